# Optimizing an MI355X kernel written in HIP

```python
import math
import jax, jax.numpy as jnp
from jax import lax
import numpy as np

D_MODEL = 2048
BATCH = 4
SEQ = 8192
DEPTH = 1

N_META = 16
LEAD = 128
N_PAD = LEAD - N_META

MIX_WIDTH = D_MODEL
ATTN_HEADS = 8
ATTN_QK_DIM = 64
ATTN_V_DIM = 2 * ATTN_QK_DIM
ATTN_WIDTH = ATTN_HEADS * ATTN_V_DIM
DN_HEADS = 8
DN_DK = 128
DN_DV = 128
DN_WIDTH = DN_HEADS * DN_DV
CONV_K = 4
CHUNK = 64
Q_BLOCK = 128
FFN_HIDDEN = -(-8 * D_MODEL // (3 * 256)) * 256
EPS = 1e-6
NEG = -1e30

A_Q = ATTN_HEADS * 2 * ATTN_QK_DIM
A_K = ATTN_HEADS * 2 * ATTN_QK_DIM
A_V = ATTN_WIDTH
D_Q = DN_HEADS * DN_DK
D_K = DN_HEADS * DN_DK
D_V = DN_WIDTH
D_Z = DN_WIDTH
D_B = DN_HEADS
D_A = DN_HEADS
COL_SIZES = (A_Q, A_K, A_V, D_Q, D_K, D_V, D_Z, D_B, D_A)
SPLITS = tuple(int(s) for s in np.cumsum(COL_SIZES)[:-1])
IN_COLS = int(sum(COL_SIZES))
CONV_CH = D_Q + D_K + D_V

kernel_name = "hymba_diffattn_gdn_alibi_meta"


def rmsnorm(x, w):
    xf = x.astype(jnp.float32)
    y = xf * lax.rsqrt(jnp.mean(xf * xf, axis=-1, keepdims=True) + EPS)
    return (y * w.astype(jnp.float32)).astype(x.dtype)


def l2norm(x):
    return x * lax.rsqrt(jnp.sum(x * x, axis=-1, keepdims=True) + EPS)


def diff_attention(q, k, v, q_norm_w, k_norm_w, lq1, lk1, lq2, lk2, subln_w, lambda_init):
    dtype = q.dtype
    B, L = q.shape[0], q.shape[1]
    f32 = jnp.float32
    q = rmsnorm(q.reshape(B, L, ATTN_HEADS, 2, ATTN_QK_DIM), q_norm_w).astype(f32)
    k = rmsnorm(k.reshape(B, L, ATTN_HEADS, 2, ATTN_QK_DIM), k_norm_w).astype(f32)
    v = v.reshape(B, L, ATTN_HEADS, ATTN_V_DIM).astype(f32)
    lam = (jnp.exp(jnp.sum(lq1.astype(f32) * lk1.astype(f32)))
           - jnp.exp(jnp.sum(lq2.astype(f32) * lk2.astype(f32))) + lambda_init)
    slopes = 2.0 ** (-8.0 * jnp.arange(1, ATTN_HEADS + 1, dtype=f32) / ATTN_HEADS)
    kpos = jnp.arange(L)
    key_ok = kpos >= N_PAD
    key_real = kpos >= LEAD
    n_blocks = L // Q_BLOCK
    qb = jnp.moveaxis(q.reshape(B, n_blocks, Q_BLOCK, ATTN_HEADS, 2, ATTN_QK_DIM), 1, 0)
    scale = ATTN_QK_DIM ** -0.5

    def one_block(args):
        q_blk, start = args
        qpos = start + jnp.arange(Q_BLOCK)
        s = jnp.einsum('bqhmd,bkhmd->bhmqk', q_blk, k) * scale
        dist = (qpos[:, None] - kpos[None, :]).astype(f32)
        bias = jnp.where(key_real[None, :], -slopes[:, None, None] * dist, 0.0)
        allowed = (kpos[None, :] <= qpos[:, None]) & key_ok[None, :]
        s = jnp.where(allowed, s + bias[None, :, None], NEG)
        p = jax.nn.softmax(s, axis=-1)
        p = p[:, :, 0] - lam * p[:, :, 1]
        return jnp.einsum('bhqk,bkhd->bqhd', p, v)

    o = lax.map(one_block, (qb, jnp.arange(n_blocks) * Q_BLOCK))
    o = jnp.moveaxis(o, 0, 1).reshape(B, L, ATTN_HEADS, ATTN_V_DIM)
    o = rmsnorm(o, subln_w) * (1.0 - lambda_init)
    return o.reshape(B, L, ATTN_WIDTH).astype(dtype)


def causal_conv(x, w):
    L = x.shape[1]
    xp = jnp.pad(x, ((0, 0), (CONV_K - 1, 0), (0, 0)))
    return sum(xp[:, j:j + L, :] * w[:, j].astype(x.dtype) for j in range(CONV_K))


def gated_deltanet(q, k, v, z, b, a, conv_w, a_log, dt_bias, o_norm_w):
    dtype = q.dtype
    B, L = q.shape[0], q.shape[1]
    f32 = jnp.float32
    valid = jnp.arange(L) >= N_PAD
    qkv = jnp.concatenate([q, k, v], axis=-1) * valid[None, :, None].astype(dtype)
    qkv = jax.nn.silu(causal_conv(qkv, conv_w)).astype(f32)
    q, k, v = jnp.split(qkv, [D_Q, D_Q + D_K], axis=-1)
    q = l2norm(q.reshape(B, L, DN_HEADS, DN_DK)) * (DN_DK ** -0.5)
    k = l2norm(k.reshape(B, L, DN_HEADS, DN_DK))
    v = v.reshape(B, L, DN_HEADS, DN_DV)
    vmask = valid.astype(f32)[None, :, None]
    beta = jax.nn.sigmoid(b.astype(f32)) * vmask
    g = -jnp.exp(a_log.astype(f32)) * jax.nn.softplus(a.astype(f32) + dt_bias.astype(f32)) * vmask
    n = L // CHUNK

    def chunks(t):
        t = t.reshape((B, n, CHUNK) + t.shape[2:])
        return jnp.moveaxis(t, 3, 1)

    qc, kc, vc = chunks(q), chunks(k), chunks(v)
    bc = chunks(beta)
    gc = jnp.cumsum(chunks(g), axis=-1)
    idx = jnp.arange(CHUNK)
    incl = idx[:, None] >= idx[None, :]
    strict = idx[:, None] > idx[None, :]
    diff = gc[..., :, None] - gc[..., None, :]
    decay = jnp.where(incl, jnp.exp(jnp.where(incl, diff, 0.0)), 0.0)
    kb = kc * bc[..., None]
    lmat = jnp.where(strict, jnp.einsum('bhnid,bhnjd->bhnij', kb, kc) * decay, 0.0)
    tmat = lmat + jnp.eye(CHUNK, dtype=f32)
    u = lax.linalg.triangular_solve(tmat, vc * bc[..., None], left_side=True, lower=True,
                                    unit_diagonal=True)
    w = lax.linalg.triangular_solve(tmat, kb * jnp.exp(gc)[..., None], left_side=True,
                                    lower=True, unit_diagonal=True)
    qk = jnp.einsum('bhnid,bhnjd->bhnij', qc, kc) * decay

    def step(S, xs):
        q_c, k_c, u_c, w_c, qk_c, g_c = xs
        v_new = u_c - jnp.einsum('bhck,bhkv->bhcv', w_c, S)
        o = (jnp.einsum('bhck,bhkv->bhcv', q_c * jnp.exp(g_c)[..., None], S)
             + jnp.einsum('bhij,bhjv->bhiv', qk_c, v_new))
        g_last = g_c[..., -1:]
        S = (S * jnp.exp(g_last)[..., None]
             + jnp.einsum('bhck,bhcv->bhkv', k_c * jnp.exp(g_last - g_c)[..., None], v_new))
        return S, o

    xs = (jnp.moveaxis(qc, 2, 0), jnp.moveaxis(kc, 2, 0), jnp.moveaxis(u, 2, 0),
          jnp.moveaxis(w, 2, 0), jnp.moveaxis(qk, 2, 0), jnp.moveaxis(gc, 2, 0))
    S0 = jnp.zeros((B, DN_HEADS, DN_DK, DN_DV), f32)
    _, o = lax.scan(step, S0, xs)
    o = jnp.moveaxis(o, 0, 2).reshape(B, DN_HEADS, L, DN_DV).transpose(0, 2, 1, 3)
    o = rmsnorm(o, o_norm_w) * jax.nn.silu(z.reshape(B, L, DN_HEADS, DN_DV).astype(f32))
    return o.reshape(B, L, DN_WIDTH).astype(dtype)


def setup_inputs(seed: int = 0) -> dict:
    key = jax.random.key(seed)
    ks = jax.random.split(key, 20)
    f32 = jnp.float32

    def normal(k, shape, scale):
        return jax.random.normal(k, shape, f32) * scale

    def gain(k, shape):
        return 1.0 + 0.02 * jax.random.normal(k, shape, f32)

    dt = jnp.exp(jax.random.uniform(ks[13], (DEPTH, DN_HEADS), f32,
                                    math.log(1e-3), math.log(1e-1)))
    return {
        "x": normal(ks[0], (BATCH, SEQ, D_MODEL), 1.0),
        "meta_tokens": normal(ks[1], (N_META, D_MODEL), 1.0),
        "attn_norm_w": gain(ks[2], (DEPTH, D_MODEL)),
        "w_in": normal(ks[3], (DEPTH, D_MODEL, IN_COLS), D_MODEL ** -0.5),
        "q_norm_w": gain(ks[4], (DEPTH, ATTN_QK_DIM)),
        "k_norm_w": gain(ks[5], (DEPTH, ATTN_QK_DIM)),
        "lambda_q1": normal(ks[6], (DEPTH, ATTN_QK_DIM), 0.1),
        "lambda_k1": normal(ks[7], (DEPTH, ATTN_QK_DIM), 0.1),
        "lambda_q2": normal(ks[8], (DEPTH, ATTN_QK_DIM), 0.1),
        "lambda_k2": normal(ks[9], (DEPTH, ATTN_QK_DIM), 0.1),
        "subln_w": gain(ks[10], (DEPTH, ATTN_V_DIM)),
        "conv_w": normal(ks[11], (DEPTH, CONV_CH, CONV_K), CONV_K ** -0.5),
        "a_log": jnp.log(jax.random.uniform(ks[12], (DEPTH, DN_HEADS), f32, 1.0, 16.0)),
        "dt_bias": dt + jnp.log(-jnp.expm1(-dt)),
        "o_norm_w": gain(ks[14], (DEPTH, DN_DV)),
        "w_out": normal(ks[15], (DEPTH, MIX_WIDTH, D_MODEL), MIX_WIDTH ** -0.5),
        "ffn_norm_w": gain(ks[16], (DEPTH, D_MODEL)),
        "w_gate": normal(ks[17], (DEPTH, D_MODEL, FFN_HIDDEN), D_MODEL ** -0.5),
        "w_up": normal(ks[18], (DEPTH, D_MODEL, FFN_HIDDEN), D_MODEL ** -0.5),
        "w_down": normal(ks[19], (DEPTH, FFN_HIDDEN, D_MODEL), FFN_HIDDEN ** -0.5),
    }


def reference(x, meta_tokens, attn_norm_w, w_in, q_norm_w, k_norm_w, lambda_q1, lambda_k1,
              lambda_q2, lambda_k2, subln_w, conv_w, a_log, dt_bias, o_norm_w, w_out,
              ffn_norm_w, w_gate, w_up, w_down):
    B = x.shape[0]
    lead = jnp.concatenate(
        [jnp.zeros((B, N_PAD, D_MODEL), x.dtype),
         jnp.broadcast_to(meta_tokens[None].astype(x.dtype), (B, N_META, D_MODEL))], axis=1)
    h = jnp.concatenate([lead, x], axis=1)
    for l in range(DEPTH):
        lambda_init = 0.8 - 0.6 * math.exp(-0.3 * l)
        u = rmsnorm(h, attn_norm_w[l])
        proj = u @ w_in[l]
        aq, ak, av, dq, dk, dv, dz, db, da = jnp.split(proj, SPLITS, axis=-1)
        o_a = diff_attention(aq, ak, av, q_norm_w[l], k_norm_w[l], lambda_q1[l], lambda_k1[l],
                             lambda_q2[l], lambda_k2[l], subln_w[l], lambda_init)
        o_d = gated_deltanet(dq, dk, dv, dz, db, da, conv_w[l], a_log[l], dt_bias[l], o_norm_w[l])
        h = h + jnp.concatenate([o_a, o_d], axis=-1) @ w_out[l]
        u = rmsnorm(h, ffn_norm_w[l])
        h = h + (jax.nn.silu(u @ w_gate[l]) * (u @ w_up[l])) @ w_down[l]
    return h[:, LEAD:]
```

```cpp
#include <hip/hip_runtime.h>
#include <hip/hip_cooperative_groups.h>
#include <cstdio>
#include <cstdint>
#include <utility>
namespace cg = cooperative_groups;
#ifndef PROBE
#define PROBE 0
#endif
namespace pg8 {
#define PG8_LAS __attribute__((address_space(3)))
typedef unsigned short bf16_t;
typedef short bf16x8 __attribute__((ext_vector_type(8)));
typedef float f32x4 __attribute__((ext_vector_type(4)));
typedef unsigned u32x4 __attribute__((ext_vector_type(4)));
constexpr int BM = 256, BK = 64, HALF = 128, HTB = HALF * BK * 2  , STAGE_BYTES = 8 * HTB, NXCD = 8, WGM = 8;

__host__ __device__ __forceinline__ int lds_byte(int r, int c) { const int st = (r >> 4) * 2 + (c >> 5), rr = r & 15, cc = c & 31, ob = rr * 64 + cc * 2; return st * 1024 + (ob ^ (((ob >> 9) & 1) << 5)); }
__host__ __device__ __forceinline__ void stage_rc(int b, int& R, int& C) { const int st = b / 1024, sb = b % 1024, swz = sb ^ (((sb >> 9) & 1) << 5); R = (st >> 1) * 16 + swz / 64; C = (st & 1) * 32 + (swz % 64) / 2; }
__host__ __device__ __forceinline__ int perm32(int rho) { const int n = rho >> 4, i = rho & 15; return 8 * (i >> 2) + 4 * n + (i & 3); }

struct Unit { int pm, pn; };
struct Gemm { const bf16_t* A; const bf16_t* Bt; int M, N, K; };

struct StaticOrder {
    int nM, nN, nwg, G, c;
    __host__ __device__ void init(int M, int N, int G_, int c_) { nM = M / BM; nN = N / BM; nwg = nM * nN; G = G_; c = c_; }
    __host__ __device__ bool next(int i, Unit& u) const {
        const long L = (long)i * G + c; if (L >= nwg) return false;
        int wgid = (int)L; { const int q = nwg / NXCD, r = nwg % NXCD, xcd = wgid % NXCD, off = wgid / NXCD; wgid = (xcd < r ? xcd * (q + 1) : r * (q + 1) + (xcd - r) * q) + off; }
        const int nig = WGM * nN, gid = wgid / nig, fm = gid * WGM, gsz = (nM - fm) < WGM ? (nM - fm) : WGM;
        u.pm = fm + ((wgid % nig) % gsz); u.pn = (wgid % nig) / gsz; return true;
    }
    __device__ __forceinline__ void a_ready(const Unit&) const {}
    __device__ __forceinline__ void done(const Unit&) const {}
};

typedef float f32x2_t __attribute__((ext_vector_type(2))); typedef __bf16 bf16x2_t __attribute__((ext_vector_type(2)));
__device__ __forceinline__ unsigned pk2(float lo, float hi) { f32x2_t v = {lo, hi}; bf16x2_t b = __builtin_convertvector(v, bf16x2_t); return __builtin_bit_cast(unsigned, b); }
__device__ __forceinline__ u32x4 pk8(f32x4 a, f32x4 b) { u32x4 w; w.x = pk2(a[0], a[1]); w.y = pk2(a[2], a[3]); w.z = pk2(b[0], b[1]); w.w = pk2(b[2], b[3]); return w; }
__device__ __forceinline__ float silu_f(float g) { return g * __builtin_amdgcn_rcpf(1.0f + __builtin_amdgcn_exp2f(-1.4426950408889634f * g)); }

struct EpiProj {
    static constexpr bool PERM = true, AFTER_DRAIN = false;
    bf16_t* P; float* BA; const float* rstd;
    __device__ __forceinline__ void operator()(const f32x4 (&acc)[2][2][4][2], const Unit& u, int wr, int wc, int fr, int fq) const {
        const int row0 = u.pm * BM + wr * 64 + fr, colb = u.pn * BM + wc * 32 + 8 * fq;
        float rsv[2][4];
#pragma unroll
        for (int ai = 0; ai < 2; ++ai)
#pragma unroll
            for (int m = 0; m < 4; ++m) rsv[ai][m] = rstd[row0 + ai * HALF + m * 16];
#pragma unroll
        for (int ai = 0; ai < 2; ++ai)
#pragma unroll
            for (int m = 0; m < 4; ++m) { const int row = row0 + ai * HALF + m * 16; const float rs = rsv[ai][m];
#pragma unroll
                for (int bj = 0; bj < 2; ++bj) { const int col = colb + bj * HALF; const f32x4 v0 = acc[ai][bj][m][0] * rs, v1 = acc[ai][bj][m][1] * rs;
                    if (col < 7168) *(u32x4*)(P + (size_t)row * 7168 + col) = pk8(v0, v1);
                    else if (col < 7184) { float* d = BA + (size_t)row * 16 + (col - 7168); *(f32x4*)d = v0; *(f32x4*)(d + 4) = v1; } } }
    }
};
struct EpiOut {
    static constexpr bool PERM = true, AFTER_DRAIN = false;
    const float* x; float* out; bf16_t* hb; float* ss2;
    __device__ __forceinline__ void operator()(const f32x4 (&acc)[2][2][4][2], const Unit& u, int wr, int wc, int fr, int fq) const {
        const int row0 = u.pm * BM + wr * 64 + fr, colb = u.pn * BM + wc * 32 + 8 * fq;
        f32x4 pre[2][2], nxt[2][2];
#pragma unroll
        for (int bj = 0; bj < 2; ++bj) { const float* s = x + (size_t)row0 * 2048 + colb + bj * HALF; pre[bj][0] = *(const f32x4*)s; pre[bj][1] = *(const f32x4*)(s + 4); }
#pragma unroll
        for (int it = 0; it < 8; ++it) { const int ai = it >> 2, m = it & 3; const int row = row0 + ai * HALF + m * 16; float s = 0.f;
            if (it + 1 < 8) { const int rown = row0 + ((it + 1) >> 2) * HALF + ((it + 1) & 3) * 16;
#pragma unroll
                for (int bj = 0; bj < 2; ++bj) { const float* sp = x + (size_t)rown * 2048 + colb + bj * HALF; nxt[bj][0] = *(const f32x4*)sp; nxt[bj][1] = *(const f32x4*)(sp + 4); } }
#pragma unroll
            for (int bj = 0; bj < 2; ++bj) { const size_t off = (size_t)row * 2048 + colb + bj * HALF;
                const f32x4 h0 = pre[bj][0] + acc[ai][bj][m][0], h1 = pre[bj][1] + acc[ai][bj][m][1];
                *(u32x4*)(hb + off) = pk8(h0, h1);
                s += (h0[0] * h0[0] + h0[1] * h0[1]) + (h0[2] * h0[2] + h0[3] * h0[3]) + (h1[0] * h1[0] + h1[1] * h1[1]) + (h1[2] * h1[2] + h1[3] * h1[3]); }
            s += __shfl_xor(s, 16); s += __shfl_xor(s, 32);
            if (fq == 0) atomicAdd(ss2 + row, s);
#pragma unroll
            for (int bj = 0; bj < 2; ++bj) { pre[bj][0] = nxt[bj][0]; pre[bj][1] = nxt[bj][1]; } }
    }
};
struct EpiGU {
    static constexpr bool PERM = true, AFTER_DRAIN = false;
    const float* ss2; bf16_t* hid;
    __device__ __forceinline__ void operator()(const f32x4 (&acc)[2][2][4][2], const Unit& u, int wr, int wc, int fr, int fq) const {
        const int row0 = u.pm * BM + wr * 64 + fr, col = u.pn * HALF + wc * 32 + 8 * fq;
        float rsv[2][4];
#pragma unroll
        for (int ai = 0; ai < 2; ++ai)
#pragma unroll
            for (int m = 0; m < 4; ++m) rsv[ai][m] = ss2[row0 + ai * HALF + m * 16];
#pragma unroll
        for (int ai = 0; ai < 2; ++ai)
#pragma unroll
            for (int m = 0; m < 4; ++m) { const int row = row0 + ai * HALF + m * 16; const float rs = rsqrtf(rsv[ai][m] * (1.0f / 2048.0f) + 1e-6f);
                f32x4 o0, o1;
#pragma unroll
                for (int e = 0; e < 4; ++e) { o0[e] = silu_f(acc[ai][0][m][0][e] * rs) * (acc[ai][1][m][0][e] * rs); o1[e] = silu_f(acc[ai][0][m][1][e] * rs) * (acc[ai][1][m][1][e] * rs); }
                *(u32x4*)(hid + (size_t)row * 5632 + col) = pk8(o0, o1); }
    }
};
struct EpiDown {
    static constexpr bool PERM = true, AFTER_DRAIN = false;
    const bf16_t* hb; float* out;
    __device__ __forceinline__ void operator()(const f32x4 (&acc)[2][2][4][2], const Unit& u, int wr, int wc, int fr, int fq) const {
        const int row0 = u.pm * BM + wr * 64 + fr, colb = u.pn * BM + wc * 32 + 8 * fq;
        u32x4 pre[2], nxt[2];
#pragma unroll
        for (int bj = 0; bj < 2; ++bj) pre[bj] = *(const u32x4*)(hb + (size_t)row0 * 2048 + colb + bj * HALF);
#pragma unroll
        for (int it = 0; it < 8; ++it) { const int ai = it >> 2, m = it & 3; const int row = row0 + ai * HALF + m * 16;
            if (it + 1 < 8) { const int rown = row0 + ((it + 1) >> 2) * HALF + ((it + 1) & 3) * 16;
#pragma unroll
                for (int bj = 0; bj < 2; ++bj) nxt[bj] = *(const u32x4*)(hb + (size_t)rown * 2048 + colb + bj * HALF); }
#pragma unroll
            for (int bj = 0; bj < 2; ++bj) { float* d = out + (size_t)row * 2048 + colb + bj * HALF; const u32x4 h = pre[bj];
                const f32x4 r0 = {__uint_as_float(h.x << 16), __uint_as_float(h.x & 0xffff0000u), __uint_as_float(h.y << 16), __uint_as_float(h.y & 0xffff0000u)};
                const f32x4 r1 = {__uint_as_float(h.z << 16), __uint_as_float(h.z & 0xffff0000u), __uint_as_float(h.w << 16), __uint_as_float(h.w & 0xffff0000u)};
                *(f32x4*)d = r0 + acc[ai][bj][m][0]; *(f32x4*)(d + 4) = r1 + acc[ai][bj][m][1]; }
#pragma unroll
            for (int bj = 0; bj < 2; ++bj) pre[bj] = nxt[bj]; }
    }
};

template <class Epi, class Sched, bool ALIGN_EPI = false, bool SP2 = false>
__device__ __forceinline__ void gemm_phase(PG8_LAS unsigned char* lds, const Gemm g, const Sched& S, const Epi& E) {
    int tid_ = threadIdx.x; asm volatile("" : "+v"(tid_));
    const int tid = tid_, wid = __builtin_amdgcn_readfirstlane(tid >> 6), lane = tid & 63, wr = wid >> 2, wc = wid & 3, fr = lane & 15, fq = lane >> 4;
    const int K = g.K, nt = K / BK;
    unsigned voffA[2], voffB[2];
#pragma unroll
    for (int i = 0; i < 2; ++i) { int R, C; stage_rc(tid * 16 + i * 8192, R, C); const int Rb = Epi::PERM ? ((R & ~31) + perm32(R & 31)) : R;
        voffA[i] = (unsigned)(R * K + C) * 2u; voffB[i] = (unsigned)(Rb * K + C) * 2u; }
    const size_t kstep = (size_t)(BK * 2);
    const size_t hstep = (size_t)HALF * K * 2;
    const size_t tstep = 2 * hstep;
    const unsigned ldsw = (unsigned)wid * 1024u;
    const int aoff = lds_byte(wr * 64 + fr, fq * 8), boff = lds_byte(wc * 32 + fr, fq * 8);
#define PG8_SA(b, h) (((b) * 2 + (h)) * HTB)
#define PG8_SB(b, h) ((4 + (b) * 2 + (h)) * HTB)
#define PG8_STAGE(bufoff, gbase, voff) do { _Pragma("unroll") for (int _i = 0; _i < 2; ++_i) \
        __builtin_amdgcn_global_load_lds((const unsigned*)((const char*)(gbase) + (voff)[_i]), (PG8_LAS unsigned*)(lds + (bufoff) + ldsw + _i * 8192), 16, 0, 0); } while (0)
#define PG8_LDA(dst, b, h) do { _Pragma("unroll") for (int m = 0; m < 4; ++m) _Pragma("unroll") for (int k = 0; k < 2; ++k) dst[m][k] = *(const PG8_LAS bf16x8*)(lds + PG8_SA(b, h) + aoff + m * 2048 + k * 1024); } while (0)
#define PG8_LDB(dst, b, h) do { _Pragma("unroll") for (int n = 0; n < 2; ++n) _Pragma("unroll") for (int k = 0; k < 2; ++k) dst[n][k] = *(const PG8_LAS bf16x8*)(lds + PG8_SB(b, h) + boff + n * 2048 + k * 1024); } while (0)
#define PG8_MMA(ai, bj, At, Bt) do { __builtin_amdgcn_s_setprio(1); _Pragma("unroll") for (int m = 0; m < 4; ++m) _Pragma("unroll") for (int n = 0; n < 2; ++n) _Pragma("unroll") for (int k = 0; k < 2; ++k) \
        acc[ai][bj][m][n] = __builtin_amdgcn_mfma_f32_16x16x32_bf16(Bt[n][k], At[m][k], acc[ai][bj][m][n], 0, 0, 0); __builtin_amdgcn_s_setprio(0); } while (0)
#define PG8_WAIT_V(n) asm volatile("s_waitcnt vmcnt(" #n ")" ::: "memory")
#define PG8_WAIT_L(n) asm volatile("s_waitcnt lgkmcnt(" #n ")" ::: "memory")
#define PG8_BAR __builtin_amdgcn_s_barrier()
#define PG8_SCHED __builtin_amdgcn_sched_barrier(0)
    Unit cur, nxt; int ui = 0;
    if (!S.next(0, cur)) return;
    f32x4 acc[2][2][4][2];
#pragma unroll
    for (int a = 0; a < 2; ++a)
#pragma unroll
        for (int b = 0; b < 2; ++b)
#pragma unroll
            for (int m = 0; m < 4; ++m)
#pragma unroll
                for (int n = 0; n < 2; ++n) acc[a][b][m][n] = (f32x4){0.f, 0.f, 0.f, 0.f};
    bf16x8 At[4][2], B0[2][2], B1[2][2];
    const char* cA = (const char*)g.A + (size_t)cur.pm * tstep; const char* cB = (const char*)g.Bt + (size_t)cur.pn * tstep;
    S.a_ready(cur);
    if constexpr (SP2) {
        PG8_STAGE(PG8_SB(0, 0), cB, voffB); PG8_STAGE(PG8_SB(0, 1), cB + hstep, voffB); PG8_STAGE(PG8_SA(0, 0), cA, voffA); PG8_STAGE(PG8_SA(0, 1), cA + hstep, voffA);
        if (wr == 1) PG8_BAR;
        PG8_WAIT_V(2); PG8_BAR;
        PG8_STAGE(PG8_SB(1, 0), cB + kstep, voffB); PG8_STAGE(PG8_SA(1, 0), cA + kstep, voffA); PG8_STAGE(PG8_SB(1, 1), cB + hstep + kstep, voffB);
        PG8_WAIT_V(6); PG8_BAR;
    } else {
        PG8_STAGE(PG8_SB(0, 0), cB, voffB); PG8_STAGE(PG8_SA(0, 0), cA, voffA); PG8_STAGE(PG8_SB(0, 1), cB + hstep, voffB); PG8_STAGE(PG8_SA(0, 1), cA + hstep, voffA);
        if (wr == 1) PG8_BAR;
        PG8_WAIT_V(4); PG8_BAR;
        PG8_STAGE(PG8_SB(1, 0), cB + kstep, voffB); PG8_STAGE(PG8_SA(1, 0), cA + kstep, voffA); PG8_STAGE(PG8_SB(1, 1), cB + hstep + kstep, voffB);
        PG8_WAIT_V(6); PG8_BAR;
    }
    for (;;) {
        const bool has_next = S.next(ui + 1, nxt);
        const char* nA = has_next ? (const char*)g.A + (size_t)nxt.pm * tstep : cA; const char* nB = has_next ? (const char*)g.Bt + (size_t)nxt.pn * tstep : cB;
        for (int t = 0; t < nt; t += 2) {
            const bool last = (t == nt - 2);
            const char* a1 = cA + (size_t)(t + 1) * kstep;
            const char* a2 = last ? nA : cA + (size_t)(t + 2) * kstep; const char* b2 = last ? nB : cB + (size_t)(t + 2) * kstep;
            const char* a3 = a2 + kstep; const char* b3 = b2 + kstep;
            if (last && has_next) S.a_ready(nxt);
            if constexpr (SP2) {
            PG8_LDB(B0, 0, 0); PG8_LDB(B1, 0, 1); PG8_SCHED; PG8_LDA(At, 0, 0); PG8_STAGE(PG8_SA(1, 1), a1 + hstep, voffA);
            PG8_WAIT_V(8); PG8_WAIT_L(0); PG8_BAR; PG8_MMA(0, 0, At, B0); PG8_MMA(0, 1, At, B1); PG8_BAR; PG8_SCHED;
            PG8_LDA(At, 0, 1); PG8_STAGE(PG8_SB(0, 0), b2, voffB); PG8_STAGE(PG8_SB(0, 1), b2 + hstep, voffB); PG8_STAGE(PG8_SA(0, 0), a2, voffA);
            PG8_WAIT_V(8); PG8_WAIT_L(0); PG8_BAR; PG8_MMA(1, 0, At, B0); PG8_MMA(1, 1, At, B1); PG8_BAR; PG8_SCHED;
            PG8_LDB(B0, 1, 0); PG8_LDB(B1, 1, 1); PG8_SCHED; PG8_LDA(At, 1, 0); PG8_STAGE(PG8_SA(0, 1), a2 + hstep, voffA);
            PG8_WAIT_V(8); PG8_WAIT_L(0); PG8_BAR; PG8_MMA(0, 0, At, B0); PG8_MMA(0, 1, At, B1); PG8_BAR; PG8_SCHED;
            PG8_LDA(At, 1, 1); PG8_STAGE(PG8_SB(1, 0), b3, voffB); PG8_STAGE(PG8_SB(1, 1), b3 + hstep, voffB); PG8_STAGE(PG8_SA(1, 0), a3, voffA);
            PG8_WAIT_V(8); PG8_WAIT_L(0); PG8_BAR; PG8_MMA(1, 0, At, B0); PG8_MMA(1, 1, At, B1); PG8_BAR; PG8_SCHED;
            } else {
            PG8_LDB(B0, 0, 0); PG8_SCHED; PG8_LDA(At, 0, 0); PG8_STAGE(PG8_SA(1, 1), a1 + hstep, voffA);
            PG8_WAIT_L(8); PG8_BAR; PG8_WAIT_L(0); PG8_MMA(0, 0, At, B0); PG8_BAR; PG8_SCHED;
            PG8_LDB(B1, 0, 1); PG8_STAGE(PG8_SB(0, 0), b2, voffB);
            PG8_BAR; PG8_WAIT_L(0); PG8_MMA(0, 1, At, B1); PG8_BAR;
            PG8_LDA(At, 0, 1); PG8_STAGE(PG8_SA(0, 0), a2, voffA);
            PG8_BAR; PG8_WAIT_L(0); PG8_MMA(1, 0, At, B0); PG8_BAR; PG8_SCHED;
            PG8_STAGE(PG8_SB(0, 1), b2 + hstep, voffB);
            PG8_WAIT_V(6); PG8_BAR; PG8_MMA(1, 1, At, B1); PG8_BAR;
            PG8_LDB(B0, 1, 0); PG8_SCHED; PG8_LDA(At, 1, 0); PG8_STAGE(PG8_SA(0, 1), a2 + hstep, voffA);
            PG8_WAIT_L(8); PG8_BAR; PG8_WAIT_L(0); PG8_MMA(0, 0, At, B0); PG8_BAR; PG8_SCHED;
            PG8_LDB(B1, 1, 1); PG8_STAGE(PG8_SB(1, 0), b3, voffB);
            PG8_BAR; PG8_WAIT_L(0); PG8_MMA(0, 1, At, B1); PG8_BAR;
            PG8_LDA(At, 1, 1); PG8_STAGE(PG8_SA(1, 0), a3, voffA);
            PG8_BAR; PG8_WAIT_L(0); PG8_MMA(1, 0, At, B0); PG8_BAR; PG8_SCHED;
            PG8_STAGE(PG8_SB(1, 1), b3 + hstep, voffB);
            PG8_WAIT_V(6); PG8_BAR; PG8_MMA(1, 1, At, B1); PG8_BAR;
            }
        }
        if constexpr (ALIGN_EPI) { if (wr == 0) PG8_BAR; }
        if constexpr (!Epi::AFTER_DRAIN) { E(acc, cur, wr, wc, fr, fq); S.done(cur); }
        if (!has_next) break;
#pragma unroll
        for (int a = 0; a < 2; ++a)
#pragma unroll
            for (int b = 0; b < 2; ++b)
#pragma unroll
                for (int m = 0; m < 4; ++m)
#pragma unroll
                    for (int n = 0; n < 2; ++n) acc[a][b][m][n] = (f32x4){0.f, 0.f, 0.f, 0.f};
        cur = nxt; cA = nA; cB = nB; ++ui;
        if constexpr (ALIGN_EPI) { if (wr == 1) PG8_BAR; }
    }
    PG8_WAIT_V(0);
    if constexpr (!ALIGN_EPI) { if (wr == 0) PG8_BAR; }
    PG8_BAR;
    if constexpr (Epi::AFTER_DRAIN) { E.fused(acc, cur, wr, wc, fr, fq, lds, wid, lane); S.done(cur); }
#undef PG8_SA
#undef PG8_SB
#undef PG8_STAGE
#undef PG8_LDA
#undef PG8_LDB
#undef PG8_MMA
#undef PG8_WAIT_V
#undef PG8_WAIT_L
#undef PG8_BAR
#undef PG8_SCHED
}
}
#define DI __device__ __forceinline__
#define LAS __attribute__((address_space(3)))
#define GAS __attribute__((address_space(1)))
typedef LAS unsigned char lds_u8;
typedef unsigned short bf16_t;
typedef short bf16x8 __attribute__((ext_vector_type(8)));
typedef float f32x4 __attribute__((ext_vector_type(4)));
typedef float f32x16 __attribute__((ext_vector_type(16)));
typedef unsigned u32x4 __attribute__((ext_vector_type(4)));
typedef unsigned u32x2 __attribute__((ext_vector_type(2)));
using pg8::pk2; using pg8::pk8; using pg8::silu_f;

constexpr int DM = 2048, BATCH = 4, SEQ = 8192, LEAD = 128, NPAD = 112, LTOT = LEAD + SEQ  , MTOT = BATCH * LTOT  , MREAL = BATCH * SEQ  ;
constexpr int INCOLS = 7184, INPAD = 7424, PLD = 7168  , FF = 5632, NCH = LTOT / 64  , NBH = 32, NITEM = NBH * NCH  ;
constexpr float EPS = 1e-6f, LOG2E = 1.4426950408889634f;
constexpr int NWAVES = 8, NTHR = 512, LDS_BYTES = 147456, MISC_OFF = 139328  , PARAM_OFF = 139520  ;
constexpr int N_ATT_UNITS = 64 * NBH;

constexpr size_t OFF_CTL = 0;
constexpr size_t OFF_RSTD1 = 4096;
constexpr size_t OFF_SS2 = OFF_RSTD1 + (size_t)MTOT * 4;
constexpr size_t OFF_EGL = OFF_SS2 + (size_t)MREAL * 4;
constexpr size_t OFF_BAR = 512u << 10;
constexpr size_t OFF_BA = 1u << 20;
constexpr size_t OFF_WIN = 4u << 20;
constexpr size_t OFF_WOUT = OFF_WIN + (size_t)INPAD * DM * 2;
constexpr size_t OFF_WGU = OFF_WOUT + (size_t)DM * DM * 2;
constexpr size_t OFF_WD = OFF_WGU + (size_t)2 * FF * DM * 2;
constexpr size_t OFF_XB = OFF_WD + (size_t)DM * FF * 2;
constexpr size_t OFF_PROJ = OFF_XB + (size_t)MTOT * DM * 2;
constexpr size_t OFF_KGT = OFF_PROJ + (size_t)MTOT * PLD * 2;
constexpr size_t OFF_QK = OFF_KGT + (size_t)NITEM * 8192 * 2;
constexpr size_t OFF_VT = OFF_QK + (size_t)NITEM * 4096 * 2;
constexpr size_t OFF_H1B = OFF_KGT;
constexpr size_t WS_NEED = OFF_VT + (size_t)NBH * 128 * LTOT * 2;
static_assert((size_t)MREAL * DM * 2 <= WS_NEED - OFF_KGT, "H1B overlay");
constexpr size_t DN_BYTES = (size_t)NBH * LTOT * 128 * 2;
static_assert(3 * DN_BYTES <= (size_t)MREAL * DM * 4, "DN scratch in d_out");

struct Params {
    const float *x, *meta, *attn_norm_w, *w_in, *q_norm_w, *k_norm_w, *lq1, *lk1, *lq2, *lk2, *subln_w, *conv_w, *a_log, *dt_bias, *o_norm_w, *w_out, *ffn_norm_w, *w_gate, *w_up, *w_down;
    float* out; unsigned char* ws;
};
struct Ptrs {
    unsigned* ctl; float *rstd1, *ss2, *egl, *BA; bf16_t *WinT, *WoutT, *WguT, *WdT, *XB, *OCAT, *PROJ, *HID, *KGT, *QK, *VT, *H1B, *UT, *W, *QG;
};

DI float wave_sum(float v) {
#pragma unroll
    for (int o = 1; o < 64; o <<= 1) v += __shfl_xor(v, o);
    return v;
}
DI float bflo(unsigned u) { return __uint_as_float(u << 16); }
DI float bfhi(unsigned u) { return __uint_as_float(u & 0xffff0000u); }
DI bf16x8 ld16(const lds_u8* p) { return *(const LAS bf16x8*)p; }
DI f32x4 mfma16(bf16x8 a, bf16x8 b, f32x4 c) { return __builtin_amdgcn_mfma_f32_16x16x32_bf16(a, b, c, 0, 0, 0); }
DI f32x16 mfma32(bf16x8 a, bf16x8 b, f32x16 c) { return __builtin_amdgcn_mfma_f32_32x32x16_bf16(a, b, c, 0, 0, 0); }
DI float pl32_max(float m) { auto rr = __builtin_amdgcn_permlane32_swap(__float_as_uint(m), __float_as_uint(m), false, false); return fmaxf(__uint_as_float(rr[0]), __uint_as_float(rr[1])); }
DI float pl32_sum(float m) { auto rr = __builtin_amdgcn_permlane32_swap(__float_as_uint(m), __float_as_uint(m), false, false); return __uint_as_float(rr[0]) + __uint_as_float(rr[1]); }
#define LDS_FENCE() asm volatile("s_waitcnt lgkmcnt(0)" ::: "memory")
#if PROBE == 20
#define LDS_BAR() __syncthreads()
#else
#define LDS_BAR() asm volatile("s_waitcnt lgkmcnt(0)\n\ts_barrier" ::: "memory")
#endif

#define XB_TMO      128
#define XB_XCNT(j)  (256  + 64 * (j))
#define XB_XSUB(j)  (1280 + 64 * (j))
#define XB_XGEN(j)  (2304 + 64 * (j))
#define XB_TOP      3328
#define XB_TOPGEN   3392
#define XCD_BAR_WORDS 3456
#define XB_SPIN_CAP (1u << 18)

__device__ __forceinline__ unsigned xb_ld(unsigned* p)              { return __hip_atomic_load(p, __ATOMIC_RELAXED, __HIP_MEMORY_SCOPE_AGENT); }
__device__ __forceinline__ unsigned xb_add(unsigned* p, unsigned v) { return __hip_atomic_fetch_add(p, v, __ATOMIC_RELAXED, __HIP_MEMORY_SCOPE_AGENT); }
__device__ __forceinline__ unsigned xb_xcc_id() { return (unsigned)__builtin_amdgcn_s_getreg((3 << 11) | 20) & 0xFu; }
#define XB_SPIN(cond, bar) do { unsigned _sp = 0; while (cond) { __builtin_amdgcn_s_sleep(1); \
    if ((++_sp & 255u) == 0u) { if (xb_ld(&(bar)[XB_TMO])) break; if (_sp > XB_SPIN_CAP) { atomicAdd(&(bar)[XB_TMO], 1u); break; } } } } while (0)

struct XcdBarrier {
    unsigned* bar; unsigned x;
    volatile LAS unsigned* st;
};

__device__ __forceinline__ XcdBarrier xcd_barrier_post(unsigned* bar, volatile LAS unsigned* st) {
    XcdBarrier b; b.bar = bar; b.x = xb_xcc_id(); b.st = st;
    if (threadIdx.x == 0) (void)xb_add(&bar[XB_XCNT(b.x)], 1u);
    return b;
}
__device__ __forceinline__ void xcd_barrier_complete(unsigned* bar, unsigned x, unsigned& nloc, unsigned& nx) {
    const unsigned G = gridDim.x * gridDim.y * gridDim.z;
    unsigned sum, cnt, mine, sp = 0u;
    for (;;) {
        sum = 0u; cnt = 0u; mine = 0u;
#pragma unroll
        for (unsigned j = 0; j < 16; ++j) { const unsigned c = xb_ld(&bar[XB_XCNT(j)]); sum += c; cnt += (c > 0u) ? 1u : 0u; mine = (j == x) ? c : mine; }
        if (sum == G) break;
        __builtin_amdgcn_s_sleep(1);
        if ((++sp & 255u) == 0u) { if (xb_ld(&bar[XB_TMO])) break; if (sp > XB_SPIN_CAP) { atomicAdd(&bar[XB_TMO], 1u); break; } }
    }
    nloc = mine > 0u ? mine : 1u; nx = cnt > 0u ? cnt : 1u;
}

__device__ __forceinline__ void xcd_barrier(const XcdBarrier& b) {
    asm volatile("s_waitcnt vmcnt(0)" ::: "memory");
    __syncthreads();
    if (threadIdx.x == 0) {
        unsigned* bar = b.bar;
        __builtin_amdgcn_s_waitcnt(0);
        unsigned nloc = b.st[0], nx = b.st[1];
        if (nloc == 0u) { xcd_barrier_complete(bar, b.x, nloc, nx); b.st[0] = nloc; b.st[1] = nx; }
        const unsigned old = xb_add(&bar[XB_XSUB(b.x)], 1u);
        const unsigned gen = old / nloc;
        if (old + 1u == (gen + 1u) * nloc) {
            __builtin_amdgcn_fence(__ATOMIC_RELEASE, "agent");
            asm volatile("s_waitcnt vmcnt(0)" ::: "memory");
            const unsigned og = xb_add(&bar[XB_TOP], 1u);
            const unsigned tg = og / nx;
            if (og + 1u == (tg + 1u) * nx) xb_add(&bar[XB_TOPGEN], 1u);
            else XB_SPIN(xb_ld(&bar[XB_TOPGEN]) == tg, bar);
            __builtin_amdgcn_fence(__ATOMIC_ACQUIRE, "agent");
            xb_add(&bar[XB_XGEN(b.x)], 1u);
            asm volatile("s_waitcnt vmcnt(0)" ::: "memory");
        } else {
            XB_SPIN(xb_ld(&bar[XB_XGEN(b.x)]) == gen, bar);
            __builtin_amdgcn_fence(__ATOMIC_ACQUIRE, "agent");
            asm volatile("s_waitcnt vmcnt(0)" ::: "memory");
        }
    }
    __syncthreads();
}

template <int MODE>
DI void transpose_item(const float* W, int K, int N, int nblk, bf16_t* WT, const float* sc, LAS float* scr, int item, int lane) {
    const int kb = item / nblk, nb = item % nblk, k0 = 64 * kb, n0 = 32 * nb;
    const int l8 = lane & 7, kr = lane >> 3, n = n0 + 4 * l8;
    f32x4 v[8];
#pragma unroll
    for (int i = 0; i < 8; ++i) v[i] = (n < N) ? *(const f32x4*)(W + (size_t)(k0 + 8 * i + kr) * N + n) : (f32x4){0.f, 0.f, 0.f, 0.f};
#pragma unroll
    for (int i = 0; i < 8; ++i) { const int kk = 8 * i + kr; const float s_ = sc ? sc[k0 + kk] : 1.0f; LAS float* d = scr + kk * 33 + 4 * l8;
        d[0] = v[i][0] * s_; d[1] = v[i][1] * s_; d[2] = v[i][2] * s_; d[3] = v[i][3] * s_; }
    LDS_FENCE();
    const int c = lane & 7;
#pragma unroll
    for (int j = 0; j < 4; ++j) { const int nn = (lane >> 3) + 8 * j; const LAS float* s = scr + (8 * c) * 33 + nn;
        u32x4 o; o.x = pk2(s[0 * 33], s[1 * 33]); o.y = pk2(s[2 * 33], s[3 * 33]); o.z = pk2(s[4 * 33], s[5 * 33]); o.w = pk2(s[6 * 33], s[7 * 33]);
        const int ng = n0 + nn; const int row = MODE == 0 ? ng : (MODE == 1 ? ((ng >> 7) * 256 + (ng & 127)) : ((ng >> 7) * 256 + 128 + (ng & 127)));
        *(u32x4*)(WT + (size_t)row * K + k0 + 8 * c) = o; }
    LDS_FENCE();
}
DI void p0_prologue(const Params& p, const Ptrs& q, lds_u8* lds, int tid) {
    const int lane = tid & 63, wave = tid >> 6;
    const int gw = blockIdx.x * NWAVES + wave, NGW = gridDim.x * NWAVES;
    LAS float* scr = (LAS float*)(lds + wave * 16384);
    constexpr int I_IN = (DM / 64) * (INPAD / 32), I_OUT = (DM / 64) * (DM / 32), I_G = (DM / 64) * (FF / 32), I_D = (FF / 64) * (DM / 32);
    constexpr int NIT = I_IN + I_OUT + 2 * I_G + I_D;
    for (int it = gw; it < NIT; it += NGW) {
        int r = it;
        if (r < I_IN) { transpose_item<0>(p.w_in, DM, INCOLS, INPAD / 32, q.WinT, p.attn_norm_w, scr, r, lane); continue; } r -= I_IN;
        if (r < I_OUT) { transpose_item<0>(p.w_out, DM, DM, DM / 32, q.WoutT, nullptr, scr, r, lane); continue; } r -= I_OUT;
        if (r < I_G) { transpose_item<1>(p.w_gate, DM, FF, FF / 32, q.WguT, p.ffn_norm_w, scr, r, lane); continue; } r -= I_G;
        if (r < I_G) { transpose_item<2>(p.w_up, DM, FF, FF / 32, q.WguT, p.ffn_norm_w, scr, r, lane); continue; } r -= I_G;
        transpose_item<0>(p.w_down, FF, DM, DM / 32, q.WdT, nullptr, scr, r, lane);
    }
    for (int r = gw; r < MTOT; r += NGW) {
        const int b = r / LTOT, t = r - b * LTOT;
        const float* src = nullptr;
        if (t >= LEAD) src = p.x + ((size_t)b * SEQ + (t - LEAD)) * DM; else if (t >= NPAD) src = p.meta + (size_t)(t - NPAD) * DM;
        f32x4 v[8]; float ss = 0.f;
#pragma unroll
        for (int j = 0; j < 8; ++j) { v[j] = src ? ((const f32x4*)src)[64 * j + lane] : (f32x4){0.f, 0.f, 0.f, 0.f}; ss += (v[j][0] * v[j][0] + v[j][1] * v[j][1]) + (v[j][2] * v[j][2] + v[j][3] * v[j][3]); }
        ss = wave_sum(ss);
        if (lane == 0) q.rstd1[r] = rsqrtf(ss * (1.0f / DM) + EPS);
        u32x2* o = (u32x2*)(q.XB + (size_t)r * DM);
#pragma unroll
        for (int j = 0; j < 8; ++j) { u32x2 w; w.x = pk2(v[j][0], v[j][1]); w.y = pk2(v[j][2], v[j][3]); o[64 * j + lane] = w; }
    }
    for (int i = blockIdx.x * NTHR + tid; i < MREAL; i += gridDim.x * NTHR) q.ss2[i] = 0.f;
    if (blockIdx.x == 0 && tid < 64) q.ctl[tid] = 0u;
    if (blockIdx.x == 0) { unsigned* bar = (unsigned*)((unsigned char*)q.ctl + OFF_BAR); for (int i = tid; i < XCD_BAR_WORDS; i += NTHR) bar[i] = 0u; }
}

DI void qknorm_row(const Params& p, const Ptrs& q, int r, int lane) {
    bf16_t* row = q.PROJ + (size_t)r * PLD;
    u32x4 raw[4]; f32x4 w0[4], w1[4];
#pragma unroll
    for (int j = 0; j < 4; ++j) { const int col = j * 512 + lane * 8; raw[j] = *(const u32x4*)(row + col);
        const float* w = (j < 2 ? p.q_norm_w : p.k_norm_w) + (col & 63); w0[j] = *(const f32x4*)w; w1[j] = *(const f32x4*)(w + 4); }
#pragma unroll
    for (int j = 0; j < 4; ++j) {
        const int col = j * 512 + lane * 8;
        float v[8] = {bflo(raw[j].x), bfhi(raw[j].x), bflo(raw[j].y), bfhi(raw[j].y), bflo(raw[j].z), bfhi(raw[j].z), bflo(raw[j].w), bfhi(raw[j].w)};
        float ss = 0.f;
#pragma unroll
        for (int e = 0; e < 8; ++e) ss += v[e] * v[e];
        ss += __shfl_xor(ss, 1); ss += __shfl_xor(ss, 2); ss += __shfl_xor(ss, 4);
        float rs = rsqrtf(ss * (1.0f / 64.0f) + EPS);
        if (j < 2) rs *= 0.125f * LOG2E;
        u32x4 o; o.x = pk2(v[0] * rs * w0[j][0], v[1] * rs * w0[j][1]); o.y = pk2(v[2] * rs * w0[j][2], v[3] * rs * w0[j][3]); o.z = pk2(v[4] * rs * w1[j][0], v[5] * rs * w1[j][1]); o.w = pk2(v[6] * rs * w1[j][2], v[7] * rs * w1[j][3]);
        *(u32x4*)(row + col) = o;
    }
}
DI void vt_item(const Ptrs& q, lds_u8* scr, int item, int lane) {
    const int bh = item / NCH, tb = item - bh * NCH, b = bh >> 3, h = bh & 7;
    const bf16_t* src = q.PROJ + ((size_t)b * LTOT + 64 * tb) * PLD + 2048 + h * 128;
#pragma unroll 4
    for (int i = 0; i < 16; ++i) { const int tok = 4 * i + (lane >> 4), ch = lane & 15; *(LAS u32x4*)(scr + tok * 272 + ch * 16) = *(const u32x4*)(src + (size_t)tok * PLD + ch * 8); }
    LDS_FENCE();
    bf16_t* dst = q.VT + ((size_t)bh * 128) * LTOT + 64 * tb;
#pragma unroll 4
    for (int i = 0; i < 16; ++i) { const int v = 8 * i + (lane >> 3), c8 = lane & 7; unsigned e[8];
#pragma unroll
        for (int k = 0; k < 8; ++k) e[k] = *(const LAS unsigned short*)(scr + (16 * (c8 >> 1) + 4 * (2 * (k >> 2) + (c8 & 1)) + (k & 3)) * 272 + v * 2);
        u32x4 o; o.x = e[0] | (e[1] << 16); o.y = e[2] | (e[3] << 16); o.z = e[4] | (e[5] << 16); o.w = e[6] | (e[7] << 16);
        *(u32x4*)(dst + (size_t)v * LTOT + c8 * 8) = o; }
    LDS_FENCE();
}
template <int J, int QLO, int QHI> DI void t_load(f32x4 (&tq)[16], unsigned tb) {
    constexpr int lo = QLO > ((J + 1) >> 2) ? QLO : ((J + 1) >> 2);
#pragma unroll
    for (int q = lo; q < QHI; ++q) tq[q] = *(const LAS f32x4*)(uintptr_t)(tb + (J * 64 + 4 * q) * 4);
}
template <int J, int QLO, int QHI> DI void t_apply(float (&x)[64], const f32x4 (&tq)[16]) {
    const float xj = x[J];
#pragma unroll
    for (int q = QLO; q < QHI; ++q) { const f32x4 tv = tq[q]; const int i4 = 4 * q;
        if (i4 + 0 > J) x[i4 + 0] -= tv[0] * xj; if (i4 + 1 > J) x[i4 + 1] -= tv[1] * xj; if (i4 + 2 > J) x[i4 + 2] -= tv[2] * xj; if (i4 + 3 > J) x[i4 + 3] -= tv[3] * xj; }
}
template <int J> DI void solve_step(float (&x)[64], f32x4 (&tq)[16], unsigned tb) {
    constexpr int qs = (J + 1) >> 2, mid = (qs + 17) >> 1;
    t_apply<J, qs, mid>(x, tq);
    if constexpr (J + 1 < 63) t_load<J + 1, qs, mid>(tq, tb);
    t_apply<J, mid, 16>(x, tq);
    if constexpr (J + 1 < 63) t_load<J + 1, mid, 16>(tq, tb);
}
template <int... Js> DI void solve_all(float (&x)[64], f32x4 (&tq)[16], unsigned tb, std::integer_sequence<int, Js...>) { (solve_step<Js>(x, tq, tb), ...); }
DI void dn_prep_item(const Params& p, const Ptrs& q, lds_u8* lds, int item, int tid) {
    const int bh = item / NCH, n = item - bh * NCH, b = bh >> 3, h = bh & 7;
    const int lane = tid & 63, w = tid >> 6;
    LAS float* RHS1 = (LAS float*)(lds);
    LAS float* RHS2 = (LAS float*)(lds + 32768);
    lds_u8* KN = lds + 65536;
    lds_u8* QN = lds + 65536 + 17408;
    LAS float* T = (LAS float*)(lds + 100352);
    lds_u8* KGTs = lds + 116736;
    LAS float* GC = (LAS float*)(lds + 135168);
    LAS float* BETA = GC + 64;
    if (tid < 64) {
        const int t = 64 * n + tid; const size_t R = (size_t)b * LTOT + t;
        const float bv = q.BA[R * 16 + h], av = q.BA[R * 16 + 8 + h];
        const bool valid = t >= NPAD;
        const float beta = valid ? 1.0f / (1.0f + expf(-bv)) : 0.f;
        const float xs = av + p.dt_bias[h];
        const float sp = fmaxf(xs, 0.f) + log1pf(expf(-fabsf(xs)));
        const float g = valid ? -expf(p.a_log[h]) * sp : 0.f;
        float c = g;
#pragma unroll
        for (int o = 1; o < 64; o <<= 1) { const float y = __shfl_up(c, o); if (tid >= o) c += y; }
        GC[tid] = c; BETA[tid] = beta;
        if (tid == 63) q.egl[item] = expf(c);
    }
    LDS_BAR();
    {
        const float glast = GC[63];
        const int rr = tid >> 4, ch = tid & 15;
#pragma unroll
        for (int mi = 0; mi < 3; ++mi) { const int mat = 2 - mi;
            const int cc = mat * 1024 + h * 128 + ch * 8;
            f32x4 cw[8];
#pragma unroll
            for (int e = 0; e < 8; ++e) cw[e] = *(const f32x4*)(p.conv_w + (size_t)(cc + e) * 4);
#pragma unroll
            for (int half = 0; half < 2; ++half) {
                const int i = rr + 32 * half, t = 64 * n + i;
                const float gci = GC[i], bi = BETA[i];
                const bf16_t* src = q.PROJ + ((size_t)b * LTOT + t) * PLD + 3072 + cc;
                float a[8] = {0.f, 0.f, 0.f, 0.f, 0.f, 0.f, 0.f, 0.f};
#pragma unroll
                for (int j = 0; j < 4; ++j) { if (t - 3 + j >= 0) { const u32x4 raw = *(const u32x4*)(src - (ptrdiff_t)(3 - j) * PLD);
                        const float xv[8] = {bflo(raw.x), bfhi(raw.x), bflo(raw.y), bfhi(raw.y), bflo(raw.z), bfhi(raw.z), bflo(raw.w), bfhi(raw.w)};
#pragma unroll
                        for (int e = 0; e < 8; ++e) a[e] += xv[e] * cw[e][j]; } }
                float ss = 0.f;
#pragma unroll
                for (int e = 0; e < 8; ++e) { a[e] = silu_f(a[e]); ss += a[e] * a[e]; }
                if (mat < 2) { ss += __shfl_xor(ss, 1); ss += __shfl_xor(ss, 2); ss += __shfl_xor(ss, 4); ss += __shfl_xor(ss, 8); }
                if (mat == 0) {
                    const float sc = rsqrtf(ss + EPS) * 0.08838834764831845f, eg = expf(gci);
                    f32x4 y0, y1;
#pragma unroll
                    for (int e = 0; e < 4; ++e) { y0[e] = a[e] * sc; y1[e] = a[4 + e] * sc; }
                    *(LAS u32x4*)(QN + i * 272 + ch * 16) = pk8(y0, y1);
                    *(u32x4*)(q.QG + ((size_t)bh * LTOT + t) * 128 + ch * 8) = pk8(y0 * eg, y1 * eg);
                } else if (mat == 1) {
                    const float sc = rsqrtf(ss + EPS), f2 = bi * expf(gci), f3 = expf(glast - gci);
                    f32x4 y0, y1;
#pragma unroll
                    for (int e = 0; e < 4; ++e) { y0[e] = a[e] * sc; y1[e] = a[4 + e] * sc; }
                    *(LAS u32x4*)(KN + i * 272 + ch * 16) = pk8(y0, y1);
                    *(LAS f32x4*)(RHS2 + i * 128 + ch * 8) = y0 * f2; *(LAS f32x4*)(RHS2 + i * 128 + ch * 8 + 4) = y1 * f2;
#pragma unroll
                    for (int e = 0; e < 4; ++e) { *(LAS unsigned short*)(KGTs + (ch * 8 + e) * 144 + i * 2) = (unsigned short)(pk2(y0[e] * f3, 0.f) & 0xffffu);
                                                  *(LAS unsigned short*)(KGTs + (ch * 8 + 4 + e) * 144 + i * 2) = (unsigned short)(pk2(y1[e] * f3, 0.f) & 0xffffu); }
                } else {
                    f32x4 y0, y1;
#pragma unroll
                    for (int e = 0; e < 4; ++e) { y0[e] = a[e] * bi; y1[e] = a[4 + e] * bi; }
                    *(LAS f32x4*)(RHS1 + i * 128 + ch * 8) = y0; *(LAS f32x4*)(RHS1 + i * 128 + ch * 8 + 4) = y1;
                }
            }
        }
    }
    LDS_BAR();
    {
#pragma unroll
        for (int it = 0; it < 2; ++it) { const int idx = tid + NTHR * it, row = idx >> 3, c8 = idx & 7;
            *(u32x4*)(q.KGT + ((size_t)item * 128 + row) * 64 + c8 * 8) = *(const LAS u32x4*)(KGTs + row * 144 + c8 * 16); }
        const int r = lane & 15, qd = lane >> 4, mt = w >> 1;
#pragma unroll
        for (int nn = 0; nn < 2; ++nn) {
            const int nt = 2 * (w & 1) + nn;
            bf16_t* qkg = q.QK + (size_t)item * 4096;
            if (nt > mt) {
#pragma unroll
                for (int i = 0; i < 4; ++i) qkg[(16 * mt + 4 * qd + i) * 64 + 16 * nt + r] = 0;
                continue;
            }
            f32x4 kk = {0.f, 0.f, 0.f, 0.f}, qk = {0.f, 0.f, 0.f, 0.f};
#pragma unroll
            for (int ks = 0; ks < 4; ++ks) {
                const bf16x8 bk = ld16(KN + (16 * nt + r) * 272 + (32 * ks + 8 * qd) * 2);
                const bf16x8 ak = ld16(KN + (16 * mt + r) * 272 + (32 * ks + 8 * qd) * 2);
                const bf16x8 aq = ld16(QN + (16 * mt + r) * 272 + (32 * ks + 8 * qd) * 2);
                kk = mfma16(ak, bk, kk); qk = mfma16(aq, bk, qk);
            }
            const int jj = 16 * nt + r; const float gcj = GC[jj];
#pragma unroll
            for (int i = 0; i < 4; ++i) { const int ii = 16 * mt + 4 * qd + i; const float dec = expf(fminf(GC[ii] - gcj, 0.f));
                T[jj * 64 + ii] = (jj < ii) ? BETA[ii] * kk[i] * dec : 0.f;
                qkg[ii * 64 + jj] = (unsigned short)(pk2((jj <= ii) ? qk[i] * dec : 0.f, 0.f) & 0xffffu); }
        }
    }
    LDS_BAR();
    if (tid < 256) {
        const int c = tid & 127; const bool isw = tid >= 128;
        const LAS float* rhs = isw ? RHS2 : RHS1;
        unsigned tb = (unsigned)(uintptr_t)T; asm volatile("" : "+v"(tb));
        float x[64];
#pragma unroll
        for (int i = 0; i < 64; ++i) x[i] = rhs[i * 128 + c];
        f32x4 tq[16];
        t_load<0, 0, 16>(tq, tb);
        solve_all(x, tq, tb, std::make_integer_sequence<int, 63>{});
        if (!isw) {
            bf16_t* d = q.UT + ((size_t)item * 128 + c) * 64;
#pragma unroll
            for (int i = 0; i < 64; i += 8) { u32x4 o; o.x = pk2(x[i], x[i + 1]); o.y = pk2(x[i + 2], x[i + 3]); o.z = pk2(x[i + 4], x[i + 5]); o.w = pk2(x[i + 6], x[i + 7]); *(u32x4*)(d + i) = o; }
        } else {
            bf16_t* d = q.W + ((size_t)bh * LTOT + 64 * n) * 128 + c;
#pragma unroll
            for (int i = 0; i < 64; ++i) d[(size_t)i * 128] = (unsigned short)(pk2(x[i], 0.f) & 0xffffu);
        }
    }
    LDS_BAR();
}

DI void dn_prep_phase(const Params& p, const Ptrs& q, lds_u8* lds, int tid, int G) {
    const int lane = tid & 63, w = __builtin_amdgcn_readfirstlane(tid >> 6);
    LAS float* RHS1 = (LAS float*)(lds);
    LAS float* RHS2 = (LAS float*)(lds + 32768);
    lds_u8* KN = lds + 65536;
    lds_u8* QN = lds + 65536 + 17408;
    LAS float* T = (LAS float*)(lds + 100352);
    lds_u8* KGTs = lds + 116736;
    LAS float* GCW = (LAS float*)(lds + 135168);
    float x[64];
#pragma unroll
    for (int i = 0; i < 64; ++i) x[i] = 0.f;
    unsigned tb = (unsigned)(uintptr_t)T; asm volatile("" : "+v"(tb));
    int prev = -1;
    int qrow = (int)blockIdx.x * 4 + w;
    float bvn = 0.f, avn = 0.f;
    if (w >= 4) { const int it0 = blockIdx.x, bh = it0 / NCH, n = it0 - bh * NCH; const size_t R = (size_t)(bh >> 3) * LTOT + 64 * n + lane; bvn = q.BA[R * 16 + (bh & 7)]; avn = q.BA[R * 16 + 8 + (bh & 7)]; }
#pragma unroll 1
    for (int it = blockIdx.x;; it += G) {
        const bool have = it < NITEM;
        if (w >= 4) {
            if (have) {
                const int bh = it / NCH, n = it - bh * NCH, b = bh >> 3, h = bh & 7, wp = w - 4;
                LAS float* GC = GCW + wp * 128; LAS float* BETA = GC + 64;
                {   const int t = 64 * n + lane;
                    const float bv = bvn, av = avn;
                    if (it + G < NITEM) { const int i2 = it + G, bh2 = i2 / NCH, n2 = i2 - bh2 * NCH; const size_t R2 = (size_t)(bh2 >> 3) * LTOT + 64 * n2 + lane; bvn = q.BA[R2 * 16 + (bh2 & 7)]; avn = q.BA[R2 * 16 + 8 + (bh2 & 7)]; }
                    const bool valid = t >= NPAD;
                    const float beta = valid ? 1.0f / (1.0f + expf(-bv)) : 0.f;
                    const float xs = av + p.dt_bias[h];
                    const float sp = fmaxf(xs, 0.f) + log1pf(expf(-fabsf(xs)));
                    const float g = valid ? -expf(p.a_log[h]) * sp : 0.f;
                    float c = g;
#pragma unroll
                    for (int o = 1; o < 64; o <<= 1) { const float y = __shfl_up(c, o); if (lane >= o) c += y; }
                    GC[lane] = c; BETA[lane] = beta;
                    if (wp == 0 && lane == 63) q.egl[it] = expf(c);
                }
                LDS_FENCE();
                const float glast = GC[63];
                const int tq_ = tid - 256, rr = tq_ >> 4, ch = tq_ & 15;
#pragma unroll 1
                for (int mi = 0; mi < 3; ++mi) { const int mat = 2 - mi;
                    const int cc = mat * 1024 + h * 128 + ch * 8;
                    f32x4 cw[8];
#pragma unroll
                    for (int e = 0; e < 8; ++e) cw[e] = *(const f32x4*)(p.conv_w + (size_t)(cc + e) * 4);
#pragma unroll
                  for (int qp = 0; qp < 1; ++qp) {
                    u32x4 raw[4][4];
#pragma unroll
                    for (int q2 = 0; q2 < 4; ++q2) { const int t = 64 * n + rr + 16 * q2; const bf16_t* src = q.PROJ + ((size_t)b * LTOT + t) * PLD + 3072 + cc;
#pragma unroll
                        for (int j = 0; j < 4; ++j) raw[q2][j] = (t - 3 + j >= 0) ? *(const u32x4*)(src - (ptrdiff_t)(3 - j) * PLD) : (u32x4){0u, 0u, 0u, 0u}; }
#pragma unroll
                    for (int q2 = 0; q2 < 4; ++q2) { const int qr = q2;
                        const int i = rr + 16 * qr, t = 64 * n + i;
                        const float gci = GC[i], bi = BETA[i];
                        float a[8] = {0.f, 0.f, 0.f, 0.f, 0.f, 0.f, 0.f, 0.f};
#pragma unroll
                        for (int j = 0; j < 4; ++j) { const u32x4 rw = raw[q2][j];
                            const float xv[8] = {bflo(rw.x), bfhi(rw.x), bflo(rw.y), bfhi(rw.y), bflo(rw.z), bfhi(rw.z), bflo(rw.w), bfhi(rw.w)};
#pragma unroll
                            for (int e = 0; e < 8; ++e) a[e] += xv[e] * cw[e][j]; }
                        float ss = 0.f;
#pragma unroll
                        for (int e = 0; e < 8; ++e) { a[e] = silu_f(a[e]); ss += a[e] * a[e]; }
                        if (mat < 2) { ss += __shfl_xor(ss, 1); ss += __shfl_xor(ss, 2); ss += __shfl_xor(ss, 4); ss += __shfl_xor(ss, 8); }
                        if (mat == 0) {
                            const float sc = rsqrtf(ss + EPS) * 0.08838834764831845f, eg = expf(gci);
                            f32x4 y0, y1;
#pragma unroll
                            for (int e = 0; e < 4; ++e) { y0[e] = a[e] * sc; y1[e] = a[4 + e] * sc; }
                            *(LAS u32x4*)(QN + i * 272 + ch * 16) = pk8(y0, y1);
                            *(u32x4*)(q.QG + ((size_t)bh * LTOT + t) * 128 + ch * 8) = pk8(y0 * eg, y1 * eg);
                        } else if (mat == 1) {
                            const float sc = rsqrtf(ss + EPS), f2 = bi * expf(gci), f3 = expf(glast - gci);
                            f32x4 y0, y1;
#pragma unroll
                            for (int e = 0; e < 4; ++e) { y0[e] = a[e] * sc; y1[e] = a[4 + e] * sc; }
                            *(LAS u32x4*)(KN + i * 272 + ch * 16) = pk8(y0, y1);
                            *(LAS f32x4*)(RHS2 + i * 128 + ch * 8) = y0 * f2; *(LAS f32x4*)(RHS2 + i * 128 + ch * 8 + 4) = y1 * f2;
#pragma unroll
                            for (int e = 0; e < 4; ++e) { *(LAS unsigned short*)(KGTs + (ch * 8 + e) * 144 + i * 2) = (unsigned short)(pk2(y0[e] * f3, 0.f) & 0xffffu);
                                                          *(LAS unsigned short*)(KGTs + (ch * 8 + 4 + e) * 144 + i * 2) = (unsigned short)(pk2(y1[e] * f3, 0.f) & 0xffffu); }
                        } else {
                            f32x4 y0, y1;
#pragma unroll
                            for (int e = 0; e < 4; ++e) { y0[e] = a[e] * bi; y1[e] = a[4 + e] * bi; }
                            *(LAS f32x4*)(RHS1 + i * 128 + ch * 8) = y0; *(LAS f32x4*)(RHS1 + i * 128 + ch * 8 + 4) = y1;
                        }
                    }
                  }
                }
            }
        } else { if (prev >= 0) {
            const int bh = prev / NCH, n = prev - bh * NCH;
            const int c = tid & 127; const bool isw = tid >= 128;
            f32x4 tq[16];
            t_load<0, 0, 16>(tq, tb);
            solve_all(x, tq, tb, std::make_integer_sequence<int, 63>{});
            if (!isw) {
                bf16_t* d = q.UT + ((size_t)prev * 128 + c) * 64;
#pragma unroll
                for (int i = 0; i < 64; i += 8) { u32x4 o; o.x = pk2(x[i], x[i + 1]); o.y = pk2(x[i + 2], x[i + 3]); o.z = pk2(x[i + 4], x[i + 5]); o.w = pk2(x[i + 6], x[i + 7]); *(u32x4*)(d + i) = o; }
            } else {
                bf16_t* d = q.W + ((size_t)bh * LTOT + 64 * n) * 128 + c;
#pragma unroll
                for (int i = 0; i < 64; ++i) d[(size_t)i * 128] = (unsigned short)(pk2(x[i], 0.f) & 0xffffu);
            } }
#pragma unroll 1
            for (int k2 = 0; k2 < 2; ++k2) { if (qrow < MTOT) qknorm_row(p, q, qrow, lane); qrow += 4 * G; }
        }
        if (!have) break;
        LDS_BAR();
        {
            const LAS float* GC = GCW; const LAS float* BETA = GCW + 64;
            int tl = tid; asm volatile("" : "+v"(tl));
            const int lane = tl & 63;
#pragma unroll
            for (int k2 = 0; k2 < 2; ++k2) { const int idx = tl + NTHR * k2, row = idx >> 3, c8 = idx & 7;
                *(u32x4*)(q.KGT + ((size_t)it * 128 + row) * 64 + c8 * 8) = *(const LAS u32x4*)(KGTs + row * 144 + c8 * 16); }
            const int r = lane & 15, qd = lane >> 4, mt = w >> 1;
#pragma unroll
            for (int nn = 0; nn < 2; ++nn) {
                const int nt = 2 * (w & 1) + nn;
                bf16_t* qkg = q.QK + (size_t)it * 4096;
                if (nt > mt) {
#pragma unroll
                    for (int i = 0; i < 4; ++i) qkg[(16 * mt + 4 * qd + i) * 64 + 16 * nt + r] = 0;
                    continue;
                }
                f32x4 kk = {0.f, 0.f, 0.f, 0.f}, qk = {0.f, 0.f, 0.f, 0.f};
#pragma unroll
                for (int ks = 0; ks < 4; ++ks) {
                    const bf16x8 bk = ld16(KN + (16 * nt + r) * 272 + (32 * ks + 8 * qd) * 2);
                    const bf16x8 ak = ld16(KN + (16 * mt + r) * 272 + (32 * ks + 8 * qd) * 2);
                    const bf16x8 aq = ld16(QN + (16 * mt + r) * 272 + (32 * ks + 8 * qd) * 2);
                    kk = mfma16(ak, bk, kk); qk = mfma16(aq, bk, qk);
                }
                const int jj = 16 * nt + r; const float gcj = GC[jj];
#pragma unroll
                for (int i = 0; i < 4; ++i) { const int ii = 16 * mt + 4 * qd + i; const float dec = expf(fminf(GC[ii] - gcj, 0.f));
                    T[jj * 64 + ii] = (jj < ii) ? BETA[ii] * kk[i] * dec : 0.f;
                    qkg[ii * 64 + jj] = (unsigned short)(pk2((jj <= ii) ? qk[i] * dec : 0.f, 0.f) & 0xffffu); }
            }
        }
        LDS_BAR();
        if (w < 4) { int tl = tid; asm volatile("" : "+v"(tl)); const int c = tl & 127; const LAS float* rhs = (w >= 2) ? RHS2 : RHS1;
#pragma unroll
            for (int i = 0; i < 64; ++i) x[i] = rhs[i * 128 + c]; }
        LDS_BAR();
        prev = it;
    }
    if (w < 4) for (; qrow < MTOT; qrow += 4 * G) qknorm_row(p, q, qrow, lane);
}

DI void dn_scan(const Params& p, const Ptrs& q, lds_u8* lds, int bh, int tid) {
    const int lane = tid & 63, w = tid >> 6, r = lane & 15, qd = lane >> 4, ct = w >> 1, vh = w & 1, b = bh >> 3, h = bh & 7;
    lds_u8 *ST = lds, *Wt = lds + 34816, *QGt = lds + 52224, *UTt = lds + 69632, *KGTt = lds + 88064, *VNT = lds + 106496, *QKt = lds + 124928;
    LAS float* PS = (LAS float*)(lds + 134144);
    for (int i = tid; i < 34816 / 16; i += NTHR) *(LAS u32x4*)(ST + i * 16) = (u32x4){0u, 0u, 0u, 0u};
    f32x4 Sm[8];
#pragma unroll
    for (int k = 0; k < 8; ++k) Sm[k] = (f32x4){0.f, 0.f, 0.f, 0.f};
    u32x4 pw[2], pq[2], pu[2], pk[2], pqk;
#define DN_LOAD(nn) do { const size_t it_ = (size_t)bh * NCH + (nn); \
        const u32x4* gw_ = (const u32x4*)(q.W + ((size_t)bh * LTOT + 64 * (nn)) * 128); const u32x4* gq_ = (const u32x4*)(q.QG + ((size_t)bh * LTOT + 64 * (nn)) * 128); \
        const u32x4* gu_ = (const u32x4*)(q.UT + it_ * 8192); const u32x4* gk_ = (const u32x4*)(q.KGT + it_ * 8192); \
        pw[0] = gw_[tid]; pw[1] = gw_[tid + NTHR]; pq[0] = gq_[tid]; pq[1] = gq_[tid + NTHR]; pu[0] = gu_[tid]; pu[1] = gu_[tid + NTHR]; pk[0] = gk_[tid]; pk[1] = gk_[tid + NTHR]; \
        pqk = ((const u32x4*)(q.QK + it_ * 4096))[tid]; } while (0)
#define DN_STORE() do { _Pragma("unroll") for (int it_ = 0; it_ < 2; ++it_) { const int idx_ = tid + NTHR * it_; \
        *(LAS u32x4*)(Wt + (idx_ >> 4) * 272 + (idx_ & 15) * 16) = pw[it_]; *(LAS u32x4*)(QGt + (idx_ >> 4) * 272 + (idx_ & 15) * 16) = pq[it_]; \
        *(LAS u32x4*)(UTt + (idx_ >> 3) * 144 + (idx_ & 7) * 16) = pu[it_]; *(LAS u32x4*)(KGTt + (idx_ >> 3) * 144 + (idx_ & 7) * 16) = pk[it_]; } \
        *(LAS u32x4*)(QKt + (tid >> 3) * 144 + (tid & 7) * 16) = pqk; } while (0)
    f32x4 oww[4];
#pragma unroll
    for (int j = 0; j < 4; ++j) oww[j] = *(const f32x4*)(p.o_norm_w + 64 * vh + 16 * j + 4 * qd);
    u32x2 zr[4];
#pragma unroll
    for (int j = 0; j < 4; ++j) zr[j] = (u32x2){0u, 0u};
    const bf16_t* zbase = q.PROJ + ((size_t)b * LTOT + 16 * ct + r) * PLD + 6144 + h * 128 + 64 * vh + 4 * qd;
    LAS float* EGs = (LAS float*)(lds + 134656);
    if (tid < NCH) EGs[tid] = q.egl[(size_t)bh * NCH + tid];
    DN_LOAD(1); DN_STORE();
    LDS_BAR();
    f32x4 a2p[4]; float rsp = 0.f;
#pragma unroll
    for (int j = 0; j < 4; ++j) a2p[j] = (f32x4){0.f, 0.f, 0.f, 0.f};
#define DN_EMIT(np_) do { const int tp_ = 64 * (np_) + 16 * ct + r; bf16_t* orow_ = q.OCAT + ((size_t)b * SEQ + (tp_ - LEAD)) * DM + 1024 + h * 128; \
        _Pragma("unroll") for (int j = 0; j < 4; ++j) { const int v0 = 64 * vh + 16 * j + 4 * qd; const f32x4 ow = oww[j]; \
            const float z0 = bflo(zr[j].x), z1 = bfhi(zr[j].x), z2 = bflo(zr[j].y), z3 = bfhi(zr[j].y); \
            u32x2 o; o.x = pk2(a2p[j][0] * rsp * ow[0] * silu_f(z0), a2p[j][1] * rsp * ow[1] * silu_f(z1)); o.y = pk2(a2p[j][2] * rsp * ow[2] * silu_f(z2), a2p[j][3] * rsp * ow[3] * silu_f(z3)); \
            *(u32x2*)(orow_ + v0) = o; } } while (0)
#pragma unroll 1
    for (int n = 1; n < NCH; ++n) {
        const float egl = EGs[n];
        if (n >= 3) DN_EMIT(n - 1);
#pragma unroll
        for (int j = 0; j < 4; ++j) zr[j] = *(const u32x2*)(zbase + (size_t)(64 * n) * PLD + 16 * j);
        if (n + 1 < NCH) DN_LOAD(n + 1);
        f32x4 a1[4], a2[4];
#pragma unroll
        for (int j = 0; j < 4; ++j) { a1[j] = (f32x4){0.f, 0.f, 0.f, 0.f}; a2[j] = (f32x4){0.f, 0.f, 0.f, 0.f}; }
#pragma unroll
        for (int ks = 0; ks < 4; ++ks) { const bf16x8 aw = ld16(Wt + (16 * ct + r) * 272 + (32 * ks + 8 * qd) * 2), bq = ld16(QGt + (16 * ct + r) * 272 + (32 * ks + 8 * qd) * 2);
#pragma unroll
            for (int j = 0; j < 4; ++j) { const bf16x8 st = ld16(ST + (64 * vh + 16 * j + r) * 272 + (32 * ks + 8 * qd) * 2);
                a1[j] = mfma16(aw, st, a1[j]);
                a2[j] = mfma16(st, bq, a2[j]); } }
#pragma unroll
        for (int j = 0; j < 4; ++j) { const int v = 64 * vh + 16 * j + r; const u32x2 uu = *(const LAS u32x2*)(UTt + v * 144 + (16 * ct + 4 * qd) * 2);
            u32x2 o; o.x = pk2(bflo(uu.x) - a1[j][0], bfhi(uu.x) - a1[j][1]); o.y = pk2(bflo(uu.y) - a1[j][2], bfhi(uu.y) - a1[j][3]);
            *(LAS u32x2*)(VNT + v * 144 + (16 * ct + 4 * qd) * 2) = o; }
        LDS_BAR();
#pragma unroll
        for (int ks = 0; ks < 2; ++ks) { const bf16x8 bb = ld16(QKt + (16 * ct + r) * 144 + (32 * ks + 8 * qd) * 2);
#pragma unroll
            for (int j = 0; j < 4; ++j) a2[j] = mfma16(ld16(VNT + (64 * vh + 16 * j + r) * 144 + (32 * ks + 8 * qd) * 2), bb, a2[j]); }
#pragma unroll
        for (int kt = 0; kt < 8; ++kt) Sm[kt] = Sm[kt] * egl;
#pragma unroll
        for (int ks = 0; ks < 2; ++ks) { const bf16x8 bb = ld16(VNT + (16 * w + r) * 144 + (32 * ks + 8 * qd) * 2);
#pragma unroll
            for (int kt = 0; kt < 8; ++kt) Sm[kt] = mfma16(ld16(KGTt + (16 * kt + r) * 144 + (32 * ks + 8 * qd) * 2), bb, Sm[kt]); }
        {   float ps = 0.f;
#pragma unroll
            for (int j = 0; j < 4; ++j) ps += (a2[j][0] * a2[j][0] + a2[j][1] * a2[j][1]) + (a2[j][2] * a2[j][2] + a2[j][3] * a2[j][3]);
            ps += __shfl_xor(ps, 16); ps += __shfl_xor(ps, 32);
            if (qd == 0) PS[(16 * ct + r) * 2 + vh] = ps; }
        LDS_BAR();
#pragma unroll
        for (int kt = 0; kt < 8; ++kt) { u32x2 o; o.x = pk2(Sm[kt][0], Sm[kt][1]); o.y = pk2(Sm[kt][2], Sm[kt][3]); *(LAS u32x2*)(ST + (16 * w + r) * 272 + (16 * kt + 4 * qd) * 2) = o; }
        if (n + 1 < NCH) DN_STORE();
        rsp = rsqrtf((PS[(16 * ct + r) * 2] + PS[(16 * ct + r) * 2 + 1]) * (1.0f / 128.0f) + EPS);
#pragma unroll
        for (int j = 0; j < 4; ++j) a2p[j] = a2[j];
        LDS_BAR();
    }
    DN_EMIT(NCH - 1);
#undef DN_EMIT
#undef DN_LOAD
#undef DN_STORE
}

DI int crow(int r, int hi) { return (r & 3) + 8 * (r >> 2) + 4 * hi; }
DI void attn_unit(const Params& p, const Ptrs& q, lds_u8* lds, int unit, int tid, float lam, float smax2) {
    const int lane = tid & 63, w = tid >> 6, r32 = lane & 31, hi = lane >> 5, mp = w & 1, sb = w >> 1;
    const int h = 7 - (unit >> 8), iq = 63 - ((unit & 255) >> 2), b = unit & 3, bh = b * 8 + h;
    const int q0 = LEAD + 128 * iq, qpos = q0 + 32 * sb + r32, ktl = 2 * iq + 3;
    const float c = exp2f(-(float)(h + 1)) * LOG2E;
    const int Dk = (int)((2.0f * smax2 + 152.0f) / c) + 2;
    const int klo = (q0 - Dk > 128) ? ((q0 - Dk) >> 6) : 2;
    bf16x8 qf[4];
    {   const bf16_t* qrow = q.PROJ + ((size_t)b * LTOT + qpos) * PLD + h * 128 + mp * 64 + hi * 8;
#pragma unroll
        for (int d0 = 0; d0 < 4; ++d0) qf[d0] = *(const bf16x8*)(qrow + d0 * 16); }
    f32x16 O[4];
#pragma unroll
    for (int vb = 0; vb < 4; ++vb)
#pragma unroll
        for (int e = 0; e < 16; ++e) O[vb][e] = 0.f;
    float l = 0.f;
    const bf16_t* kg = q.PROJ + ((size_t)b * LTOT) * PLD + 1024 + h * 128;
    const bf16_t* vg = q.VT + ((size_t)bh * 128) * LTOT;
    const int kkey = tid >> 3, kch = tid & 7, vv = tid >> 2, vch = tid & 3;
    u32x4 pk0A, pk1A, pv0A, pv1A, pk0B, pk1B, pv0B, pv1B;
#define AT_LOAD(S, kt_) do { const bf16_t* a_ = kg + (size_t)(64 * (kt_) + kkey) * PLD + kch * 8; pk0##S = *(const u32x4*)a_; pk1##S = *(const u32x4*)(a_ + 64); \
        const bf16_t* v_ = vg + (size_t)vv * LTOT + 64 * (kt_) + vch * 8; pv0##S = *(const u32x4*)v_; pv1##S = *(const u32x4*)(v_ + 32); } while (0)
#define AT_STORE(S, buf_) do { lds_u8* kb_ = lds + (buf_) * 17408 + kkey * 272 + kch * 16; *(LAS u32x4*)kb_ = pk0##S; *(LAS u32x4*)(kb_ + 128) = pk1##S; \
          \
        lds_u8* vb_ = lds + 34816 + (buf_) * 18432 + vv * 144 + vch * 16; *(LAS u32x4*)vb_ = pv0##S; *(LAS u32x4*)(vb_ + 64) = pv1##S; } while (0)
#define AT_NEXT(k_) (((k_) > klo) ? (k_) - 1 : ((k_) > 1 ? 1 : 0))
    AT_LOAD(A, ktl);
    { const int k1_ = AT_NEXT(ktl); if (k1_) AT_LOAD(B, k1_); }
    AT_STORE(A, 0);
    LDS_BAR();
    int kt = ktl; bool done = false;
#pragma unroll 1
    while (!done) {
#pragma unroll
      for (int cur = 0; cur < 2; ++cur) {
        const int knext = AT_NEXT(kt), knn = knext ? AT_NEXT(knext) : 0;
        if (knn) { if (cur) AT_LOAD(B, knn); else AT_LOAD(A, knn); }
        const lds_u8* Kb = lds + cur * 17408; const lds_u8* Vb = lds + 34816 + cur * 18432;
        const bool first = (kt == 1);
        const float ce = first ? 0.f : c;
        const float b0 = first ? 0.f : c * (float)(64 * kt + 4 * hi - qpos);
        f32x16 S0, S1;
#pragma unroll
        for (int e = 0; e < 16; ++e) { S0[e] = 0.f; S1[e] = 0.f; }
        bf16x8 kf0[4], kf1[4];
#pragma unroll
        for (int d0 = 0; d0 < 4; ++d0) { kf0[d0] = ld16(Kb + r32 * 272 + mp * 128 + d0 * 32 + hi * 16); kf1[d0] = ld16(Kb + (32 + r32) * 272 + mp * 128 + d0 * 32 + hi * 16); }
        __builtin_amdgcn_sched_barrier(0);
#pragma unroll
        for (int d0 = 0; d0 < 4; ++d0) { S0 = mfma32(kf0[d0], qf[d0], S0); S1 = mfma32(kf1[d0], qf[d0], S1); }
#define AT_VFRAG(g_) ld16(Vb + (32 * ((g_) >> 2) + r32) * 144 + (32 * (((g_) >> 1) & 1) + 16 * ((g_) & 1) + 8 * hi) * 2)
        bf16x8 vfa[8];
#pragma unroll
        for (int g = 0; g < 8; ++g) vfa[g] = AT_VFRAG(g);
        __builtin_amdgcn_sched_barrier(0);
#pragma unroll
        for (int e = 0; e < 16; ++e) { const float kr = (float)((e & 3) + 8 * (e >> 2)); S0[e] = fmaf(ce, kr, S0[e]); S1[e] = fmaf(ce, kr + 32.0f, S1[e]); }
        if (first) {
            asm volatile("");
#pragma unroll
            for (int e = 0; e < 16; ++e) { S0[e] = -INFINITY; if (e < 8) S1[e] = -INFINITY; }
        }
        if (kt >= ktl - 1) {
            asm volatile("");
            const int kb0 = 64 * kt + 4 * hi;
#pragma unroll
            for (int e = 0; e < 16; ++e) { const int key = kb0 + (e & 3) + 8 * (e >> 2); if (key > qpos) S0[e] = -INFINITY; if (key + 32 > qpos) S1[e] = -INFINITY; }
        }
        const float mb = smax2 - b0;
        float sum = 0.f;
#pragma unroll
        for (int e = 0; e < 16; ++e) { S0[e] = __builtin_amdgcn_exp2f(S0[e] - mb); S1[e] = __builtin_amdgcn_exp2f(S1[e] - mb); sum += S0[e] + S1[e]; }
        l += sum;
        bf16x8 pf[2][2];
#pragma unroll
        for (int ks = 0; ks < 2; ++ks) {
            u32x4 t0, t1;
            t0.x = pk2(S0[8 * ks + 0], S0[8 * ks + 1]); t0.y = pk2(S0[8 * ks + 2], S0[8 * ks + 3]); t0.z = pk2(S0[8 * ks + 4], S0[8 * ks + 5]); t0.w = pk2(S0[8 * ks + 6], S0[8 * ks + 7]);
            t1.x = pk2(S1[8 * ks + 0], S1[8 * ks + 1]); t1.y = pk2(S1[8 * ks + 2], S1[8 * ks + 3]); t1.z = pk2(S1[8 * ks + 4], S1[8 * ks + 5]); t1.w = pk2(S1[8 * ks + 6], S1[8 * ks + 7]);
            pf[0][ks] = __builtin_bit_cast(bf16x8, t0); pf[1][ks] = __builtin_bit_cast(bf16x8, t1);
        }
        __builtin_amdgcn_sched_barrier(0);
#pragma unroll
        for (int g = 0; g < 4; ++g) O[0] = mfma32(vfa[g], pf[(g >> 1) & 1][g & 1], O[0]);
#pragma unroll
        for (int g = 0; g < 4; ++g) vfa[g] = AT_VFRAG(8 + g);
        __builtin_amdgcn_sched_barrier(0);
#pragma unroll
        for (int g = 4; g < 8; ++g) O[1] = mfma32(vfa[g], pf[(g >> 1) & 1][g & 1], O[1]);
#pragma unroll
        for (int g = 4; g < 8; ++g) vfa[g] = AT_VFRAG(8 + g);
        __builtin_amdgcn_sched_barrier(0);
#pragma unroll
        for (int g = 0; g < 4; ++g) O[2] = mfma32(vfa[g], pf[(g >> 1) & 1][g & 1], O[2]);
#pragma unroll
        for (int g = 4; g < 8; ++g) O[3] = mfma32(vfa[g], pf[(g >> 1) & 1][g & 1], O[3]);
#undef AT_VFRAG
        if (knext) { if (cur) AT_STORE(A, 0); else AT_STORE(B, 1); }
        LDS_BAR();
        if (!knext) { done = true; break; }
        kt = knext;
      }
    }
#undef AT_NEXT
#undef AT_LOAD
#undef AT_STORE
    const float inv = 1.0f / pl32_sum(l);
    LAS float* comb = (LAS float*)lds + sb * 4096;
    if (mp == 1) {
#pragma unroll
        for (int vb = 0; vb < 4; ++vb)
#pragma unroll
            for (int e = 0; e < 16; ++e) comb[(32 * vb + crow(e, hi)) * 32 + r32] = O[vb][e] * inv;
    }
    LDS_BAR();
    if (mp == 0) {
        float ss = 0.f;
#pragma unroll
        for (int vb = 0; vb < 4; ++vb)
#pragma unroll
            for (int e = 0; e < 16; ++e) { const float o = O[vb][e] * inv - lam * comb[(32 * vb + crow(e, hi)) * 32 + r32]; O[vb][e] = o; ss += o * o; }
        ss = pl32_sum(ss);
        const float rs = rsqrtf(ss * (1.0f / 128.0f) + EPS) * 0.8f;
        bf16_t* orow = q.OCAT + ((size_t)b * SEQ + (qpos - LEAD)) * DM + h * 128;
        u32x2 ov[4][4];
#pragma unroll
        for (int vb = 0; vb < 4; ++vb)
#pragma unroll
            for (int g = 0; g < 4; ++g) { const int v0 = 32 * vb + 8 * g + 4 * hi; const f32x4 sw = *(const f32x4*)(p.subln_w + v0);
                ov[vb][g].x = pk2(O[vb][4 * g] * rs * sw[0], O[vb][4 * g + 1] * rs * sw[1]); ov[vb][g].y = pk2(O[vb][4 * g + 2] * rs * sw[2], O[vb][4 * g + 3] * rs * sw[3]); }
#pragma unroll
        for (int vb = 0; vb < 4; ++vb)
#pragma unroll
            for (int g = 0; g < 4; ++g) *(u32x2*)(orow + 32 * vb + 8 * g + 4 * hi) = ov[vb][g];
    }
    LDS_BAR();
}

DI void attn_unit2(const Params& p, const Ptrs& q, lds_u8* lds, int unit, int tid, float lam, float smax2) {
    const int lane = tid & 63, w = tid >> 6, r32 = lane & 31, hi = lane >> 5, mp = w & 1, sb = w >> 1;
    const int h = 7 - (unit >> 8), iq = 63 - ((unit & 255) >> 2), b = unit & 3, bh = b * 8 + h;
    const int q0 = LEAD + 128 * iq, qpos = q0 + 32 * sb + r32, ktl = 2 * iq + 3;
    const float c = exp2f(-(float)(h + 1)) * LOG2E;
    const int Dk = (int)((2.0f * smax2 + 152.0f) / c) + 2;
    const int klo = (q0 - Dk > 128) ? ((q0 - Dk) >> 6) : 2;
    bf16x8 qf[4];
    {   const bf16_t* qrow = q.PROJ + ((size_t)b * LTOT + qpos) * PLD + h * 128 + mp * 64 + hi * 8;
#pragma unroll
        for (int d0 = 0; d0 < 4; ++d0) qf[d0] = *(const bf16x8*)(qrow + d0 * 16); }
    f32x16 O[4];
#pragma unroll
    for (int vb = 0; vb < 4; ++vb)
#pragma unroll
        for (int e = 0; e < 16; ++e) O[vb][e] = 0.f;
    float l = 0.f;
    const bf16_t* kg = q.PROJ + ((size_t)b * LTOT) * PLD + 1024 + h * 128;
    const bf16_t* vg = q.VT + ((size_t)bh * 128) * LTOT;
    const int kkey = tid >> 3, kch = tid & 7, vv = tid >> 2, vch = tid & 3;
    u32x4 pk0A, pk1A, pv0A, pv1A, pk0B, pk1B, pv0B, pv1B;
#define A2_LOADK(S, kt_) do { const bf16_t* a_ = kg + (size_t)(64 * (kt_) + kkey) * PLD + kch * 8; pk0##S = *(const u32x4*)a_; pk1##S = *(const u32x4*)(a_ + 64); } while (0)
#define A2_LOADV(S, kt_) do { const bf16_t* v_ = vg + (size_t)vv * LTOT + 64 * (kt_) + vch * 8; pv0##S = *(const u32x4*)v_; pv1##S = *(const u32x4*)(v_ + 32); } while (0)
#define A2_STOREK(S, buf_) do { lds_u8* kb_ = lds + (buf_) * 17408 + kkey * 272 + kch * 16; *(LAS u32x4*)kb_ = pk0##S; *(LAS u32x4*)(kb_ + 128) = pk1##S; } while (0)
#define A2_STOREV(S, buf_) do { lds_u8* vb_ = lds + 34816 + (buf_) * 17408 + vv * 136 + vch * 16; *(LAS u32x2*)vb_ = (u32x2){pv0##S.x, pv0##S.y}; *(LAS u32x2*)(vb_ + 8) = (u32x2){pv0##S.z, pv0##S.w}; \
        *(LAS u32x2*)(vb_ + 64) = (u32x2){pv1##S.x, pv1##S.y}; *(LAS u32x2*)(vb_ + 72) = (u32x2){pv1##S.z, pv1##S.w}; } while (0)
#define A2_NEXT(k_) (((k_) > klo) ? (k_) - 1 : ((k_) > 1 ? 1 : 0))
#define A2_QK(kt_, Kb_) \
        const bool first = ((kt_) == 1); const float ce = first ? 0.f : c; const float b0 = first ? 0.f : c * (float)(64 * (kt_) + 4 * hi - qpos); \
        f32x16 S0, S1; \
        _Pragma("unroll") for (int e = 0; e < 16; ++e) { S0[e] = 0.f; S1[e] = 0.f; } \
        _Pragma("unroll") for (int d0 = 0; d0 < 4; ++d0) { \
            const bf16x8 a0 = ld16((Kb_) + r32 * 272 + mp * 128 + d0 * 32 + hi * 16), a1 = ld16((Kb_) + (32 + r32) * 272 + mp * 128 + d0 * 32 + hi * 16); \
            S0 = mfma32(a0, qf[d0], S0); S1 = mfma32(a1, qf[d0], S1); } \
        const float mb = smax2 - b0;
#define A2_BIAS(kt_) \
        _Pragma("unroll") for (int e = 0; e < 16; ++e) { const float kr = (float)((e & 3) + 8 * (e >> 2)); S0[e] = fmaf(ce, kr, S0[e]); S1[e] = fmaf(ce, kr + 32.0f, S1[e]); } \
        if (first) { asm volatile(""); _Pragma("unroll") for (int e = 0; e < 16; ++e) { S0[e] = -INFINITY; if (e < 8) S1[e] = -INFINITY; } } \
        if ((kt_) >= ktl - 1) { asm volatile(""); const int kb0 = 64 * (kt_) + 4 * hi; \
            _Pragma("unroll") for (int e = 0; e < 16; ++e) { const int key = kb0 + (e & 3) + 8 * (e >> 2); if (key > qpos) S0[e] = -INFINITY; if (key + 32 > qpos) S1[e] = -INFINITY; } }
#define A2_PACK(dst) do { _Pragma("unroll") for (int ks = 0; ks < 2; ++ks) { u32x4 t0, t1; \
            t0.x = pk2(S0[8 * ks + 0], S0[8 * ks + 1]); t0.y = pk2(S0[8 * ks + 2], S0[8 * ks + 3]); t0.z = pk2(S0[8 * ks + 4], S0[8 * ks + 5]); t0.w = pk2(S0[8 * ks + 6], S0[8 * ks + 7]); \
            t1.x = pk2(S1[8 * ks + 0], S1[8 * ks + 1]); t1.y = pk2(S1[8 * ks + 2], S1[8 * ks + 3]); t1.z = pk2(S1[8 * ks + 4], S1[8 * ks + 5]); t1.w = pk2(S1[8 * ks + 6], S1[8 * ks + 7]); \
            dst[0][ks] = __builtin_bit_cast(bf16x8, t0); dst[1][ks] = __builtin_bit_cast(bf16x8, t1); } } while (0)
#define A2_VFRAG(Vb_, g_) ({ const lds_u8* ap_ = (Vb_) + (32 * ((g_) >> 2) + r32) * 136 + (32 * (((g_) >> 1) & 1) + 16 * ((g_) & 1) + 4 * hi) * 2; \
        const u32x2 lo_ = *(const LAS u32x2*)ap_, hh_ = *(const LAS u32x2*)(ap_ + 16); const u32x4 av_ = {lo_.x, lo_.y, hh_.x, hh_.y}; __builtin_bit_cast(bf16x8, av_); })
    bf16x8 pf[2][2];
    const int k0 = ktl, k1 = A2_NEXT(k0), k2 = k1 ? A2_NEXT(k1) : 0;
    A2_LOADK(A, k0);
    if (k1) A2_LOADK(B, k1);
    A2_LOADV(B, k0);
    A2_STOREK(A, 0);
    LDS_BAR();
    {
        if (k2) A2_LOADK(A, k2);
        if (k1) A2_LOADV(A, k1);
        A2_QK(k0, lds)
        A2_BIAS(k0)
        float sum = 0.f;
#pragma unroll
        for (int e = 0; e < 16; ++e) { S0[e] = __builtin_amdgcn_exp2f(S0[e] - mb); S1[e] = __builtin_amdgcn_exp2f(S1[e] - mb); sum += S0[e] + S1[e]; }
        l += sum;
        A2_PACK(pf);
        if (k1) A2_STOREK(B, 1);
        A2_STOREV(B, 0);
        LDS_BAR();
    }
    int kt = k1, lastpar = 0; bool done = (k1 == 0);
#pragma unroll 1
    while (!done) {
#pragma unroll
      for (int cc = 0; cc < 2; ++cc) { const int par = cc ^ 1;
        const int knext = A2_NEXT(kt), knn = knext ? A2_NEXT(knext) : 0;
        if (par) { if (knn) A2_LOADK(B, knn); if (knext) A2_LOADV(B, knext); } else { if (knn) A2_LOADK(A, knn); if (knext) A2_LOADV(A, knext); }
        const lds_u8* Kb = lds + par * 17408; const lds_u8* Vb = lds + 34816 + (par ^ 1) * 17408;
        A2_QK(kt, Kb)
        bf16x8 vf0 = A2_VFRAG(Vb, 0), vf1;
        A2_BIAS(kt)
        float sum = 0.f;
#pragma unroll
        for (int g = 0; g < 16; ++g) {
            if (g + 1 < 16) { if (g & 1) vf0 = A2_VFRAG(Vb, g + 1); else vf1 = A2_VFRAG(Vb, g + 1); }
            O[g >> 2] = mfma32((g & 1) ? vf1 : vf0, pf[(g >> 1) & 1][g & 1], O[g >> 2]);
            S0[g] = __builtin_amdgcn_exp2f(S0[g] - mb); S1[g] = __builtin_amdgcn_exp2f(S1[g] - mb); sum += S0[g] + S1[g];
            __builtin_amdgcn_sched_barrier(0);
        }
        l += sum;
        A2_PACK(pf);
        if (par) { if (knext) A2_STOREK(A, 0); A2_STOREV(A, 1); } else { if (knext) A2_STOREK(B, 1); A2_STOREV(B, 0); }
        LDS_BAR();
        lastpar = par;
        if (!knext) { done = true; break; }
        kt = knext;
      }
    }
    {
        const lds_u8* Vb = lds + 34816 + lastpar * 17408;
#pragma unroll
        for (int g = 0; g < 16; ++g) O[g >> 2] = mfma32(A2_VFRAG(Vb, g), pf[(g >> 1) & 1][g & 1], O[g >> 2]);
        LDS_BAR();
    }
#undef A2_LOADK
#undef A2_LOADV
#undef A2_STOREK
#undef A2_STOREV
#undef A2_NEXT
#undef A2_QK
#undef A2_BIAS
#undef A2_PACK
#undef A2_VFRAG
    const float inv = 1.0f / pl32_sum(l);
    LAS float* comb = (LAS float*)lds + sb * 4096;
    if (mp == 1) {
#pragma unroll
        for (int vb = 0; vb < 4; ++vb)
#pragma unroll
            for (int e = 0; e < 16; ++e) comb[(32 * vb + crow(e, hi)) * 32 + r32] = O[vb][e] * inv;
    }
    LDS_BAR();
    if (mp == 0) {
        float ss = 0.f;
#pragma unroll
        for (int vb = 0; vb < 4; ++vb)
#pragma unroll
            for (int e = 0; e < 16; ++e) { const float o = O[vb][e] * inv - lam * comb[(32 * vb + crow(e, hi)) * 32 + r32]; O[vb][e] = o; ss += o * o; }
        ss = pl32_sum(ss);
        const float rs = rsqrtf(ss * (1.0f / 128.0f) + EPS) * 0.8f;
        bf16_t* orow = q.OCAT + ((size_t)b * SEQ + (qpos - LEAD)) * DM + h * 128;
        u32x2 ov[4][4];
#pragma unroll
        for (int vb = 0; vb < 4; ++vb)
#pragma unroll
            for (int g = 0; g < 4; ++g) { const int v0 = 32 * vb + 8 * g + 4 * hi; const f32x4 sw = *(const f32x4*)(p.subln_w + v0);
                ov[vb][g].x = pk2(O[vb][4 * g] * rs * sw[0], O[vb][4 * g + 1] * rs * sw[1]); ov[vb][g].y = pk2(O[vb][4 * g + 2] * rs * sw[2], O[vb][4 * g + 3] * rs * sw[3]); }
#pragma unroll
        for (int vb = 0; vb < 4; ++vb)
#pragma unroll
            for (int g = 0; g < 4; ++g) *(u32x2*)(orow + 32 * vb + 8 * g + 4 * hi) = ov[vb][g];
    }
    LDS_BAR();
}

DI unsigned long long rd_u64(const LAS unsigned long long* a) { const unsigned long long v = *a; const unsigned lo = __builtin_amdgcn_readfirstlane((unsigned)v), hi = __builtin_amdgcn_readfirstlane((unsigned)(v >> 32)); return ((unsigned long long)hi << 32) | lo; }
#define PARAM_FIELDS(X) X(x,0) X(meta,1) X(attn_norm_w,2) X(w_in,3) X(q_norm_w,4) X(k_norm_w,5) X(lq1,6) X(lk1,7) X(lq2,8) X(lk2,9) X(subln_w,10) X(conv_w,11) X(a_log,12) X(dt_bias,13) X(o_norm_w,14) X(w_out,15) X(ffn_norm_w,16) X(w_gate,17) X(w_up,18) X(w_down,19)
DI Params load_params(const lds_u8* lds) {
    const LAS unsigned long long* PL = (const LAS unsigned long long*)(lds + PARAM_OFF); Params p;
#define X(f, i) p.f = (const float*)(const GAS float*)rd_u64(PL + i);
    PARAM_FIELDS(X)
#undef X
    p.out = (float*)(GAS float*)rd_u64(PL + 20); p.ws = (unsigned char*)(GAS unsigned char*)rd_u64(PL + 21);
    return p;
}
DI Ptrs make_ptrs(const Params& p) {
    Ptrs q; unsigned char* ws = p.ws;
    q.ctl = (unsigned*)(ws + OFF_CTL); q.rstd1 = (float*)(ws + OFF_RSTD1); q.ss2 = (float*)(ws + OFF_SS2); q.egl = (float*)(ws + OFF_EGL); q.BA = (float*)(ws + OFF_BA);
    q.WinT = (bf16_t*)(ws + OFF_WIN); q.WoutT = (bf16_t*)(ws + OFF_WOUT); q.WguT = (bf16_t*)(ws + OFF_WGU); q.WdT = (bf16_t*)(ws + OFF_WD);
    q.XB = (bf16_t*)(ws + OFF_XB); q.OCAT = q.XB; q.PROJ = (bf16_t*)(ws + OFF_PROJ); q.HID = q.PROJ;
    q.KGT = (bf16_t*)(ws + OFF_KGT); q.QK = (bf16_t*)(ws + OFF_QK); q.VT = (bf16_t*)(ws + OFF_VT); q.H1B = (bf16_t*)(ws + OFF_H1B);
    unsigned char* o = (unsigned char*)p.out; q.UT = (bf16_t*)o; q.W = (bf16_t*)(o + DN_BYTES); q.QG = (bf16_t*)(o + 2 * DN_BYTES);
    return q;
}
__global__ void __launch_bounds__(NTHR, 2) hymba_fwd(Params pk) {
    extern __shared__ __attribute__((aligned(16))) unsigned char lds_raw[];
    cg::grid_group grid = cg::this_grid();
    lds_u8* lds = (lds_u8*)lds_raw;
    const int tid = threadIdx.x;
    if (tid == 0) { LAS unsigned long long* PL = (LAS unsigned long long*)(lds + PARAM_OFF);
#define X(f, i) PL[i] = (unsigned long long)pk.f;
        PARAM_FIELDS(X)
#undef X
        PL[20] = (unsigned long long)pk.out; PL[21] = (unsigned long long)pk.ws;
        ((LAS unsigned*)(lds + MISC_OFF))[8] = 0u; ((LAS unsigned*)(lds + MISC_OFF))[9] = 0u; }
    __syncthreads();
    const int G = gridDim.x;

    {   const Params p = load_params(lds); const Ptrs q = make_ptrs(p);
        int t0 = threadIdx.x; asm volatile("" : "+v"(t0));
        p0_prologue(p, q, lds, t0);
#if PROBE == 10
        __syncthreads(); p0_prologue(p, q, lds, t0);
#endif
        }
    grid.sync();
    const XcdBarrier xbar = xcd_barrier_post((unsigned*)(pk.ws + OFF_BAR), (volatile LAS unsigned*)(lds + MISC_OFF) + 8);
    {   const Params p = load_params(lds); const Ptrs q = make_ptrs(p);
        pg8::Gemm g{q.XB, q.WinT, MTOT, INPAD, DM}; pg8::StaticOrder S; S.init(MTOT, INPAD, G, (int)blockIdx.x);
        pg8::EpiProj E{q.PROJ, q.BA, q.rstd1};
        pg8::gemm_phase<pg8::EpiProj, pg8::StaticOrder, true, true>(lds, g, S, E);
#if PROBE == 1
        __syncthreads(); pg8::gemm_phase<pg8::EpiProj, pg8::StaticOrder, true, true>(lds, g, S, E);
#endif
        }
    xcd_barrier(xbar);
    {   const Params p = load_params(lds); const Ptrs q = make_ptrs(p);
        int t2 = threadIdx.x; asm volatile("" : "+v"(t2)); const int tid = t2, lane = tid & 63, wave = __builtin_amdgcn_readfirstlane(tid >> 6);
        const int gw = blockIdx.x * NWAVES + wave, NGW = G * NWAVES;
#if PROBE == 23
        for (int r = gw; r < MTOT; r += NGW) qknorm_row(p, q, r, lane);
#endif
        for (int it = gw; it < NITEM; it += NGW) vt_item(q, lds + wave * 17408, it, lane);
        __syncthreads();
#if PROBE == 23
        for (int it = blockIdx.x; it < NITEM; it += G) dn_prep_item(p, q, lds, it, tid);
#else
        dn_prep_phase(p, q, lds, tid, G);
#endif
#if PROBE == 2 || PROBE == 21
        for (int it = gw; it < NITEM; it += NGW) vt_item(q, lds + wave * 17408, it, lane);
        __syncthreads();
#endif
#if PROBE == 2 || PROBE == 22
        for (int it = blockIdx.x; it < NITEM; it += G) dn_prep_item(p, q, lds, it, tid);
#endif
        }
    xcd_barrier(xbar);
    {   const Params p = load_params(lds); const Ptrs q = make_ptrs(p);
        int t3 = threadIdx.x; asm volatile("" : "+v"(t3)); const int tid = t3;
        if ((int)blockIdx.x < NBH) dn_scan(p, q, lds, (int)blockIdx.x, tid);
#if PROBE == 4
        if ((int)blockIdx.x < NBH) { __syncthreads(); dn_scan(p, q, lds, (int)blockIdx.x, tid); }
#endif
        float s1 = 0.f, s2 = 0.f;
        for (int i = 0; i < 64; ++i) { s1 += p.lq1[i] * p.lk1[i]; s2 += p.lq2[i] * p.lk2[i]; }
        const float lam = expf(s1) - expf(s2) + 0.2f;
        float qwm = 0.f, kwm = 0.f;
        for (int i = 0; i < 64; ++i) { qwm = fmaxf(qwm, fabsf(p.q_norm_w[i])); kwm = fmaxf(kwm, fabsf(p.k_norm_w[i])); }
        const float smax2 = 8.0f * qwm * kwm * LOG2E * 1.03f;
        volatile LAS unsigned* misc = (volatile LAS unsigned*)(lds + MISC_OFF);
        const int xcd = (int)(__builtin_amdgcn_s_getreg((3 << 11) | 20) & 7u);
        int xstart = xcd;
        for (;;) {
            if (tid == 0) { unsigned code = 0xffffffffu; int xx = xstart;
                for (int a = 0; a < 8; ++a) { const unsigned j = atomicAdd(q.ctl + 8 * xx, 1u); if (j < 256u) { code = ((unsigned)xx << 8) | j; break; } xx = (xx + 1) & 7; }
                xstart = xx; misc[0] = code; }
            __syncthreads();
            const unsigned code = (unsigned)__builtin_amdgcn_readfirstlane((int)misc[0]);
            if (code == 0xffffffffu) break;
            const int xq = (int)(code >> 8), jq = (int)(code & 255u), slot = jq >> 6;
            const int hq = (xq < 4) ? (slot == 0 ? 7 : slot == 1 ? 5 : slot == 2 ? 2 : 0) : (slot == 0 ? 6 : slot == 1 ? 4 : slot == 2 ? 3 : 1);
            const int u = (7 - hq) * 256 + (jq & 63) * 4 + (xq & 3);
#if PROBE == 30
            attn_unit2(p, q, lds, u, tid, lam, smax2);
#else
            attn_unit(p, q, lds, u, tid, lam, smax2);
#endif
        } }
    xcd_barrier(xbar);
#if PROBE == 3
    {   const Params p = load_params(lds); const Ptrs q = make_ptrs(p);
        if (blockIdx.x == 0 && threadIdx.x == 0) q.ctl[0] = 0u;
        grid.sync();
        int t3 = threadIdx.x; asm volatile("" : "+v"(t3)); const int tid = t3;
        if ((int)blockIdx.x < NBH) dn_scan(p, q, lds, (int)blockIdx.x, tid);
        float s1 = 0.f, s2 = 0.f;
        for (int i = 0; i < 64; ++i) { s1 += p.lq1[i] * p.lk1[i]; s2 += p.lq2[i] * p.lk2[i]; }
        const float lam = expf(s1) - expf(s2) + 0.2f;
        float qwm = 0.f, kwm = 0.f;
        for (int i = 0; i < 64; ++i) { qwm = fmaxf(qwm, fabsf(p.q_norm_w[i])); kwm = fmaxf(kwm, fabsf(p.k_norm_w[i])); }
        const float smax2 = 8.0f * qwm * kwm * LOG2E * 1.03f;
        volatile LAS unsigned* misc = (volatile LAS unsigned*)(lds + MISC_OFF);
        for (;;) {
            if (tid == 0) misc[0] = atomicAdd(q.ctl, 1u);
            __syncthreads();
            const int u = __builtin_amdgcn_readfirstlane((int)misc[0]);
            if (u >= N_ATT_UNITS) break;
#if PROBE == 30
            attn_unit2(p, q, lds, u, tid, lam, smax2);
#else
            attn_unit(p, q, lds, u, tid, lam, smax2);
#endif
        } }
    grid.sync();
#endif
    {   const Params p = load_params(lds); const Ptrs q = make_ptrs(p);
        pg8::Gemm g{q.OCAT, q.WoutT, MREAL, DM, DM}; pg8::StaticOrder S; S.init(MREAL, DM, G, (int)blockIdx.x);
        pg8::EpiOut E{p.x, p.out, q.H1B, q.ss2};
        pg8::gemm_phase<pg8::EpiOut, pg8::StaticOrder, true, true>(lds, g, S, E); }
    xcd_barrier(xbar);
    {   const Params p = load_params(lds); const Ptrs q = make_ptrs(p);
        pg8::Gemm g{q.H1B, q.WguT, MREAL, 2 * FF, DM}; pg8::StaticOrder S; S.init(MREAL, 2 * FF, G, (int)blockIdx.x);
        pg8::EpiGU E{q.ss2, q.HID};
        pg8::gemm_phase<pg8::EpiGU, pg8::StaticOrder, true, true>(lds, g, S, E);
#if PROBE == 5
        __syncthreads(); pg8::gemm_phase<pg8::EpiGU, pg8::StaticOrder, true, true>(lds, g, S, E);
#endif
        }
    xcd_barrier(xbar);
    {   const Params p = load_params(lds); const Ptrs q = make_ptrs(p);
        pg8::Gemm g{q.HID, q.WdT, MREAL, DM, FF}; pg8::StaticOrder S; S.init(MREAL, DM, G, (int)blockIdx.x);
        pg8::EpiDown E{q.H1B, p.out};
        pg8::gemm_phase<pg8::EpiDown, pg8::StaticOrder, true, true>(lds, g, S, E); }
}

extern "C" void kernel_launch(void* const* d_in, const int* in_sizes, int n_in, void* d_out, int out_size, void* d_ws, size_t ws_size, hipStream_t stream) {
    static int grid = 0;
    if (grid == 0) {
        if (n_in != 20 || out_size != MREAL * DM || ws_size < WS_NEED) { fprintf(stderr, "kernel_launch: unexpected shapes (n_in %d, out %d, ws %zu, need %zu)\n", n_in, out_size, ws_size, (size_t)WS_NEED); grid = -1; return; }
        int dev = 0, cus = 0, per_cu = 0;
        hipGetDevice(&dev); hipDeviceGetAttribute(&cus, hipDeviceAttributeMultiprocessorCount, dev);
        if (hipFuncSetAttribute((const void*)hymba_fwd, hipFuncAttributeMaxDynamicSharedMemorySize, LDS_BYTES) != hipSuccess) { fprintf(stderr, "kernel_launch: hipFuncSetAttribute failed\n"); grid = -1; return; }
        if (hipOccupancyMaxActiveBlocksPerMultiprocessor(&per_cu, (const void*)hymba_fwd, NTHR, LDS_BYTES) != hipSuccess || per_cu < 1) { fprintf(stderr, "kernel_launch: occupancy query says %d\n", per_cu); per_cu = 1; }
        (void)hipGetLastError();
        grid = cus;
    }
    if (grid < 0) return;
    Params p{};
    const float** pp = (const float**)&p;
    for (int i = 0; i < 20; ++i) pp[i] = (const float*)d_in[i];
    p.out = (float*)d_out; p.ws = (unsigned char*)d_ws;
    void* args[] = {&p};
    hipError_t e = hipLaunchCooperativeKernel((const void*)hymba_fwd, dim3(grid), dim3(NTHR), args, LDS_BYTES, stream);
    if (e != hipSuccess) fprintf(stderr, "kernel_launch: cooperative launch failed: %s (grid %d)\n", hipGetErrorString(e), grid);
}
```

```cpp
#include <hip/hip_runtime.h>
#include <hip/hip_cooperative_groups.h>
#include <cstdio>
#include <cstdint>
#include <utility>
namespace cg = cooperative_groups;
#ifndef PROBE
#define PROBE 0
#endif
namespace pg8 {
#define PG8_LAS __attribute__((address_space(3)))
typedef unsigned short bf16_t;
typedef short bf16x8 __attribute__((ext_vector_type(8)));
typedef float f32x4 __attribute__((ext_vector_type(4)));
typedef unsigned u32x4 __attribute__((ext_vector_type(4)));
constexpr int BM = 256, BK = 64, HALF = 128, HTB = HALF * BK * 2  , STAGE_BYTES = 8 * HTB, NXCD = 8, WGM = 8;

__host__ __device__ __forceinline__ int lds_byte(int r, int c) { const int st = (r >> 4) * 2 + (c >> 5), rr = r & 15, cc = c & 31, ob = rr * 64 + cc * 2; return st * 1024 + (ob ^ (((ob >> 9) & 1) << 5)); }
__host__ __device__ __forceinline__ void stage_rc(int b, int& R, int& C) { const int st = b / 1024, sb = b % 1024, swz = sb ^ (((sb >> 9) & 1) << 5); R = (st >> 1) * 16 + swz / 64; C = (st & 1) * 32 + (swz % 64) / 2; }
__host__ __device__ __forceinline__ int perm32(int rho) { const int n = rho >> 4, i = rho & 15; return 8 * (i >> 2) + 4 * n + (i & 3); }

struct Unit { int pm, pn; };
struct Gemm { const bf16_t* A; const bf16_t* Bt; int M, N, K; };

struct StaticOrder {
    int nM, nN, nwg, G, c;
    __host__ __device__ void init(int M, int N, int G_, int c_) { nM = M / BM; nN = N / BM; nwg = nM * nN; G = G_; c = c_; }
    __host__ __device__ bool next(int i, Unit& u) const {
        const long L = (long)i * G + c; if (L >= nwg) return false;
        int wgid = (int)L; { const int q = nwg / NXCD, r = nwg % NXCD, xcd = wgid % NXCD, off = wgid / NXCD; wgid = (xcd < r ? xcd * (q + 1) : r * (q + 1) + (xcd - r) * q) + off; }
        const int nig = WGM * nN, gid = wgid / nig, fm = gid * WGM, gsz = (nM - fm) < WGM ? (nM - fm) : WGM;
        u.pm = fm + ((wgid % nig) % gsz); u.pn = (wgid % nig) / gsz; return true;
    }
    __device__ __forceinline__ void a_ready(const Unit&) const {}
    __device__ __forceinline__ void done(const Unit&) const {}
};

typedef float f32x2_t __attribute__((ext_vector_type(2))); typedef __bf16 bf16x2_t __attribute__((ext_vector_type(2)));
__device__ __forceinline__ unsigned pk2(float lo, float hi) { f32x2_t v = {lo, hi}; bf16x2_t b = __builtin_convertvector(v, bf16x2_t); return __builtin_bit_cast(unsigned, b); }
__device__ __forceinline__ u32x4 pk8(f32x4 a, f32x4 b) { u32x4 w; w.x = pk2(a[0], a[1]); w.y = pk2(a[2], a[3]); w.z = pk2(b[0], b[1]); w.w = pk2(b[2], b[3]); return w; }
__device__ __forceinline__ float silu_f(float g) { return g * __builtin_amdgcn_rcpf(1.0f + __builtin_amdgcn_exp2f(-1.4426950408889634f * g)); }

struct EpiProj {
    static constexpr bool PERM = true, AFTER_DRAIN = false;
    bf16_t* P; float* BA; const float* rstd;
    __device__ __forceinline__ void operator()(const f32x4 (&acc)[2][2][4][2], const Unit& u, int wr, int wc, int fr, int fq) const {
        const int row0 = u.pm * BM + wr * 64 + fr, colb = u.pn * BM + wc * 32 + 8 * fq;
        float rsv[2][4];
#pragma unroll
        for (int ai = 0; ai < 2; ++ai)
#pragma unroll
            for (int m = 0; m < 4; ++m) rsv[ai][m] = rstd[row0 + ai * HALF + m * 16];
#pragma unroll
        for (int ai = 0; ai < 2; ++ai)
#pragma unroll
            for (int m = 0; m < 4; ++m) { const int row = row0 + ai * HALF + m * 16; const float rs = rsv[ai][m];
#pragma unroll
                for (int bj = 0; bj < 2; ++bj) { const int col = colb + bj * HALF; const f32x4 v0 = acc[ai][bj][m][0] * rs, v1 = acc[ai][bj][m][1] * rs;
                    if (col < 7168) *(u32x4*)(P + (size_t)row * 7168 + col) = pk8(v0, v1);
                    else if (col < 7184) { float* d = BA + (size_t)row * 16 + (col - 7168); *(f32x4*)d = v0; *(f32x4*)(d + 4) = v1; } } }
    }
};
struct EpiOut {
    static constexpr bool PERM = true, AFTER_DRAIN = false;
    const float* x; float* out; bf16_t* hb; float* ss2;
    __device__ __forceinline__ void operator()(const f32x4 (&acc)[2][2][4][2], const Unit& u, int wr, int wc, int fr, int fq) const {
        const int row0 = u.pm * BM + wr * 64 + fr, colb = u.pn * BM + wc * 32 + 8 * fq;
        f32x4 pre[2][2], nxt[2][2];
#pragma unroll
        for (int bj = 0; bj < 2; ++bj) { const float* s = x + (size_t)row0 * 2048 + colb + bj * HALF; pre[bj][0] = *(const f32x4*)s; pre[bj][1] = *(const f32x4*)(s + 4); }
#pragma unroll
        for (int it = 0; it < 8; ++it) { const int ai = it >> 2, m = it & 3; const int row = row0 + ai * HALF + m * 16; float s = 0.f;
            if (it + 1 < 8) { const int rown = row0 + ((it + 1) >> 2) * HALF + ((it + 1) & 3) * 16;
#pragma unroll
                for (int bj = 0; bj < 2; ++bj) { const float* sp = x + (size_t)rown * 2048 + colb + bj * HALF; nxt[bj][0] = *(const f32x4*)sp; nxt[bj][1] = *(const f32x4*)(sp + 4); } }
#pragma unroll
            for (int bj = 0; bj < 2; ++bj) { const size_t off = (size_t)row * 2048 + colb + bj * HALF;
                const f32x4 h0 = pre[bj][0] + acc[ai][bj][m][0], h1 = pre[bj][1] + acc[ai][bj][m][1];
                *(u32x4*)(hb + off) = pk8(h0, h1);
                s += (h0[0] * h0[0] + h0[1] * h0[1]) + (h0[2] * h0[2] + h0[3] * h0[3]) + (h1[0] * h1[0] + h1[1] * h1[1]) + (h1[2] * h1[2] + h1[3] * h1[3]); }
            s += __shfl_xor(s, 16); s += __shfl_xor(s, 32);
            if (fq == 0) atomicAdd(ss2 + row, s);
#pragma unroll
            for (int bj = 0; bj < 2; ++bj) { pre[bj][0] = nxt[bj][0]; pre[bj][1] = nxt[bj][1]; } }
    }
};
struct EpiGU {
    static constexpr bool PERM = true, AFTER_DRAIN = false;
    const float* ss2; bf16_t* hid;
    __device__ __forceinline__ void operator()(const f32x4 (&acc)[2][2][4][2], const Unit& u, int wr, int wc, int fr, int fq) const {
        const int row0 = u.pm * BM + wr * 64 + fr, col = u.pn * HALF + wc * 32 + 8 * fq;
        float rsv[2][4];
#pragma unroll
        for (int ai = 0; ai < 2; ++ai)
#pragma unroll
            for (int m = 0; m < 4; ++m) rsv[ai][m] = ss2[row0 + ai * HALF + m * 16];
#pragma unroll
        for (int ai = 0; ai < 2; ++ai)
#pragma unroll
            for (int m = 0; m < 4; ++m) { const int row = row0 + ai * HALF + m * 16; const float rs = rsqrtf(rsv[ai][m] * (1.0f / 2048.0f) + 1e-6f);
                f32x4 o0, o1;
#pragma unroll
                for (int e = 0; e < 4; ++e) { o0[e] = silu_f(acc[ai][0][m][0][e] * rs) * (acc[ai][1][m][0][e] * rs); o1[e] = silu_f(acc[ai][0][m][1][e] * rs) * (acc[ai][1][m][1][e] * rs); }
                *(u32x4*)(hid + (size_t)row * 5632 + col) = pk8(o0, o1); }
    }
};
struct EpiDown {
    static constexpr bool PERM = true, AFTER_DRAIN = false;
    const bf16_t* hb; float* out;
    __device__ __forceinline__ void operator()(const f32x4 (&acc)[2][2][4][2], const Unit& u, int wr, int wc, int fr, int fq) const {
        const int row0 = u.pm * BM + wr * 64 + fr, colb = u.pn * BM + wc * 32 + 8 * fq;
        u32x4 pre[2], nxt[2];
#pragma unroll
        for (int bj = 0; bj < 2; ++bj) pre[bj] = *(const u32x4*)(hb + (size_t)row0 * 2048 + colb + bj * HALF);
#pragma unroll
        for (int it = 0; it < 8; ++it) { const int ai = it >> 2, m = it & 3; const int row = row0 + ai * HALF + m * 16;
            if (it + 1 < 8) { const int rown = row0 + ((it + 1) >> 2) * HALF + ((it + 1) & 3) * 16;
#pragma unroll
                for (int bj = 0; bj < 2; ++bj) nxt[bj] = *(const u32x4*)(hb + (size_t)rown * 2048 + colb + bj * HALF); }
#pragma unroll
            for (int bj = 0; bj < 2; ++bj) { float* d = out + (size_t)row * 2048 + colb + bj * HALF; const u32x4 h = pre[bj];
                const f32x4 r0 = {__uint_as_float(h.x << 16), __uint_as_float(h.x & 0xffff0000u), __uint_as_float(h.y << 16), __uint_as_float(h.y & 0xffff0000u)};
                const f32x4 r1 = {__uint_as_float(h.z << 16), __uint_as_float(h.z & 0xffff0000u), __uint_as_float(h.w << 16), __uint_as_float(h.w & 0xffff0000u)};
                *(f32x4*)d = r0 + acc[ai][bj][m][0]; *(f32x4*)(d + 4) = r1 + acc[ai][bj][m][1]; }
#pragma unroll
            for (int bj = 0; bj < 2; ++bj) pre[bj] = nxt[bj]; }
    }
};

template <class Epi, class Sched, bool ALIGN_EPI = false, bool SP2 = false>
__device__ __forceinline__ void gemm_phase(PG8_LAS unsigned char* lds, const Gemm g, const Sched& S, const Epi& E) {
    int tid_ = threadIdx.x; asm volatile("" : "+v"(tid_));
    const int tid = tid_, wid = __builtin_amdgcn_readfirstlane(tid >> 6), lane = tid & 63, wr = wid >> 2, wc = wid & 3, fr = lane & 15, fq = lane >> 4;
    const int K = g.K, nt = K / BK;
    unsigned voffA[2], voffB[2];
#pragma unroll
    for (int i = 0; i < 2; ++i) { int R, C; stage_rc(tid * 16 + i * 8192, R, C); const int Rb = Epi::PERM ? ((R & ~31) + perm32(R & 31)) : R;
        voffA[i] = (unsigned)(R * K + C) * 2u; voffB[i] = (unsigned)(Rb * K + C) * 2u; }
    const size_t kstep = (size_t)(BK * 2);
    const size_t hstep = (size_t)HALF * K * 2;
    const size_t tstep = 2 * hstep;
    const unsigned ldsw = (unsigned)wid * 1024u;
    const int aoff = lds_byte(wr * 64 + fr, fq * 8), boff = lds_byte(wc * 32 + fr, fq * 8);
#define PG8_SA(b, h) (((b) * 2 + (h)) * HTB)
#define PG8_SB(b, h) ((4 + (b) * 2 + (h)) * HTB)
#define PG8_STAGE(bufoff, gbase, voff) do { _Pragma("unroll") for (int _i = 0; _i < 2; ++_i) \
        __builtin_amdgcn_global_load_lds((const unsigned*)((const char*)(gbase) + (voff)[_i]), (PG8_LAS unsigned*)(lds + (bufoff) + ldsw + _i * 8192), 16, 0, 0); } while (0)
#define PG8_LDA(dst, b, h) do { _Pragma("unroll") for (int m = 0; m < 4; ++m) _Pragma("unroll") for (int k = 0; k < 2; ++k) dst[m][k] = *(const PG8_LAS bf16x8*)(lds + PG8_SA(b, h) + aoff + m * 2048 + k * 1024); } while (0)
#define PG8_LDB(dst, b, h) do { _Pragma("unroll") for (int n = 0; n < 2; ++n) _Pragma("unroll") for (int k = 0; k < 2; ++k) dst[n][k] = *(const PG8_LAS bf16x8*)(lds + PG8_SB(b, h) + boff + n * 2048 + k * 1024); } while (0)
#define PG8_MMA(ai, bj, At, Bt) do { __builtin_amdgcn_s_setprio(1); _Pragma("unroll") for (int m = 0; m < 4; ++m) _Pragma("unroll") for (int n = 0; n < 2; ++n) _Pragma("unroll") for (int k = 0; k < 2; ++k) \
        acc[ai][bj][m][n] = __builtin_amdgcn_mfma_f32_16x16x32_bf16(Bt[n][k], At[m][k], acc[ai][bj][m][n], 0, 0, 0); __builtin_amdgcn_s_setprio(0); } while (0)
#define PG8_WAIT_V(n) asm volatile("s_waitcnt vmcnt(" #n ")" ::: "memory")
#define PG8_WAIT_L(n) asm volatile("s_waitcnt lgkmcnt(" #n ")" ::: "memory")
#define PG8_BAR __builtin_amdgcn_s_barrier()
#define PG8_SCHED __builtin_amdgcn_sched_barrier(0)
    Unit cur, nxt; int ui = 0;
    if (!S.next(0, cur)) return;
    f32x4 acc[2][2][4][2];
#pragma unroll
    for (int a = 0; a < 2; ++a)
#pragma unroll
        for (int b = 0; b < 2; ++b)
#pragma unroll
            for (int m = 0; m < 4; ++m)
#pragma unroll
                for (int n = 0; n < 2; ++n) acc[a][b][m][n] = (f32x4){0.f, 0.f, 0.f, 0.f};
    bf16x8 At[4][2], B0[2][2], B1[2][2];
    const char* cA = (const char*)g.A + (size_t)cur.pm * tstep; const char* cB = (const char*)g.Bt + (size_t)cur.pn * tstep;
    S.a_ready(cur);
    if constexpr (SP2) {
        PG8_STAGE(PG8_SB(0, 0), cB, voffB); PG8_STAGE(PG8_SB(0, 1), cB + hstep, voffB); PG8_STAGE(PG8_SA(0, 0), cA, voffA); PG8_STAGE(PG8_SA(0, 1), cA + hstep, voffA);
        if (wr == 1) PG8_BAR;
        PG8_WAIT_V(2); PG8_BAR;
        PG8_STAGE(PG8_SB(1, 0), cB + kstep, voffB); PG8_STAGE(PG8_SA(1, 0), cA + kstep, voffA); PG8_STAGE(PG8_SB(1, 1), cB + hstep + kstep, voffB);
        PG8_WAIT_V(6); PG8_BAR;
    } else {
        PG8_STAGE(PG8_SB(0, 0), cB, voffB); PG8_STAGE(PG8_SA(0, 0), cA, voffA); PG8_STAGE(PG8_SB(0, 1), cB + hstep, voffB); PG8_STAGE(PG8_SA(0, 1), cA + hstep, voffA);
        if (wr == 1) PG8_BAR;
        PG8_WAIT_V(4); PG8_BAR;
        PG8_STAGE(PG8_SB(1, 0), cB + kstep, voffB); PG8_STAGE(PG8_SA(1, 0), cA + kstep, voffA); PG8_STAGE(PG8_SB(1, 1), cB + hstep + kstep, voffB);
        PG8_WAIT_V(6); PG8_BAR;
    }
    for (;;) {
        const bool has_next = S.next(ui + 1, nxt);
        const char* nA = has_next ? (const char*)g.A + (size_t)nxt.pm * tstep : cA; const char* nB = has_next ? (const char*)g.Bt + (size_t)nxt.pn * tstep : cB;
        for (int t = 0; t < nt; t += 2) {
            const bool last = (t == nt - 2);
            const char* a1 = cA + (size_t)(t + 1) * kstep;
            const char* a2 = last ? nA : cA + (size_t)(t + 2) * kstep; const char* b2 = last ? nB : cB + (size_t)(t + 2) * kstep;
            const char* a3 = a2 + kstep; const char* b3 = b2 + kstep;
            if (last && has_next) S.a_ready(nxt);
            if constexpr (SP2) {
            PG8_LDB(B0, 0, 0); PG8_LDB(B1, 0, 1); PG8_SCHED; PG8_LDA(At, 0, 0); PG8_STAGE(PG8_SA(1, 1), a1 + hstep, voffA);
            PG8_WAIT_V(8); PG8_WAIT_L(0); PG8_BAR; PG8_MMA(0, 0, At, B0); PG8_MMA(0, 1, At, B1); PG8_BAR; PG8_SCHED;
            PG8_LDA(At, 0, 1); PG8_STAGE(PG8_SB(0, 0), b2, voffB); PG8_STAGE(PG8_SB(0, 1), b2 + hstep, voffB); PG8_STAGE(PG8_SA(0, 0), a2, voffA);
            PG8_WAIT_V(8); PG8_WAIT_L(0); PG8_BAR; PG8_MMA(1, 0, At, B0); PG8_MMA(1, 1, At, B1); PG8_BAR; PG8_SCHED;
            PG8_LDB(B0, 1, 0); PG8_LDB(B1, 1, 1); PG8_SCHED; PG8_LDA(At, 1, 0); PG8_STAGE(PG8_SA(0, 1), a2 + hstep, voffA);
            PG8_WAIT_V(8); PG8_WAIT_L(0); PG8_BAR; PG8_MMA(0, 0, At, B0); PG8_MMA(0, 1, At, B1); PG8_BAR; PG8_SCHED;
            PG8_LDA(At, 1, 1); PG8_STAGE(PG8_SB(1, 0), b3, voffB); PG8_STAGE(PG8_SB(1, 1), b3 + hstep, voffB); PG8_STAGE(PG8_SA(1, 0), a3, voffA);
            PG8_WAIT_V(8); PG8_WAIT_L(0); PG8_BAR; PG8_MMA(1, 0, At, B0); PG8_MMA(1, 1, At, B1); PG8_BAR; PG8_SCHED;
            } else {
            PG8_LDB(B0, 0, 0); PG8_SCHED; PG8_LDA(At, 0, 0); PG8_STAGE(PG8_SA(1, 1), a1 + hstep, voffA);
            PG8_WAIT_L(8); PG8_BAR; PG8_WAIT_L(0); PG8_MMA(0, 0, At, B0); PG8_BAR; PG8_SCHED;
            PG8_LDB(B1, 0, 1); PG8_STAGE(PG8_SB(0, 0), b2, voffB);
            PG8_BAR; PG8_WAIT_L(0); PG8_MMA(0, 1, At, B1); PG8_BAR;
            PG8_LDA(At, 0, 1); PG8_STAGE(PG8_SA(0, 0), a2, voffA);
            PG8_BAR; PG8_WAIT_L(0); PG8_MMA(1, 0, At, B0); PG8_BAR; PG8_SCHED;
            PG8_STAGE(PG8_SB(0, 1), b2 + hstep, voffB);
            PG8_WAIT_V(6); PG8_BAR; PG8_MMA(1, 1, At, B1); PG8_BAR;
            PG8_LDB(B0, 1, 0); PG8_SCHED; PG8_LDA(At, 1, 0); PG8_STAGE(PG8_SA(0, 1), a2 + hstep, voffA);
            PG8_WAIT_L(8); PG8_BAR; PG8_WAIT_L(0); PG8_MMA(0, 0, At, B0); PG8_BAR; PG8_SCHED;
            PG8_LDB(B1, 1, 1); PG8_STAGE(PG8_SB(1, 0), b3, voffB);
            PG8_BAR; PG8_WAIT_L(0); PG8_MMA(0, 1, At, B1); PG8_BAR;
            PG8_LDA(At, 1, 1); PG8_STAGE(PG8_SA(1, 0), a3, voffA);
            PG8_BAR; PG8_WAIT_L(0); PG8_MMA(1, 0, At, B0); PG8_BAR; PG8_SCHED;
            PG8_STAGE(PG8_SB(1, 1), b3 + hstep, voffB);
            PG8_WAIT_V(6); PG8_BAR; PG8_MMA(1, 1, At, B1); PG8_BAR;
            }
        }
        if constexpr (ALIGN_EPI) { if (wr == 0) PG8_BAR; }
        if constexpr (!Epi::AFTER_DRAIN) { E(acc, cur, wr, wc, fr, fq); S.done(cur); }
        if (!has_next) break;
#pragma unroll
        for (int a = 0; a < 2; ++a)
#pragma unroll
            for (int b = 0; b < 2; ++b)
#pragma unroll
                for (int m = 0; m < 4; ++m)
#pragma unroll
                    for (int n = 0; n < 2; ++n) acc[a][b][m][n] = (f32x4){0.f, 0.f, 0.f, 0.f};
        cur = nxt; cA = nA; cB = nB; ++ui;
        if constexpr (ALIGN_EPI) { if (wr == 1) PG8_BAR; }
    }
    PG8_WAIT_V(0);
    if constexpr (!ALIGN_EPI) { if (wr == 0) PG8_BAR; }
    PG8_BAR;
    if constexpr (Epi::AFTER_DRAIN) { E.fused(acc, cur, wr, wc, fr, fq, lds, wid, lane); S.done(cur); }
#undef PG8_SA
#undef PG8_SB
#undef PG8_STAGE
#undef PG8_LDA
#undef PG8_LDB
#undef PG8_MMA
#undef PG8_WAIT_V
#undef PG8_WAIT_L
#undef PG8_BAR
#undef PG8_SCHED
}
}
#define DI __device__ __forceinline__
#define LAS __attribute__((address_space(3)))
#define GAS __attribute__((address_space(1)))
typedef LAS unsigned char lds_u8;
typedef unsigned short bf16_t;
typedef short bf16x8 __attribute__((ext_vector_type(8)));
typedef float f32x4 __attribute__((ext_vector_type(4)));
typedef float f32x16 __attribute__((ext_vector_type(16)));
typedef unsigned u32x4 __attribute__((ext_vector_type(4)));
typedef unsigned u32x2 __attribute__((ext_vector_type(2)));
using pg8::pk2; using pg8::pk8; using pg8::silu_f;

constexpr int DM = 2048, BATCH = 4, SEQ = 8192, LEAD = 128, NPAD = 112, LTOT = LEAD + SEQ  , MTOT = BATCH * LTOT  , MREAL = BATCH * SEQ  ;
constexpr int INCOLS = 7184, INPAD = 7424, PLD = 7168  , FF = 5632, NCH = LTOT / 64  , NBH = 32, NITEM = NBH * NCH  ;
constexpr float EPS = 1e-6f, LOG2E = 1.4426950408889634f;
constexpr int NWAVES = 8, NTHR = 512, LDS_BYTES = 147456, MISC_OFF = 139328  , PARAM_OFF = 139520  ;
constexpr int N_ATT_UNITS = 64 * NBH;

constexpr size_t OFF_CTL = 0;
constexpr size_t OFF_RSTD1 = 4096;
constexpr size_t OFF_SS2 = OFF_RSTD1 + (size_t)MTOT * 4;
constexpr size_t OFF_EGL = OFF_SS2 + (size_t)MREAL * 4;
constexpr size_t OFF_BAR = 512u << 10;
constexpr size_t OFF_BA = 1u << 20;
constexpr size_t OFF_WIN = 4u << 20;
constexpr size_t OFF_WOUT = OFF_WIN + (size_t)INPAD * DM * 2;
constexpr size_t OFF_WGU = OFF_WOUT + (size_t)DM * DM * 2;
constexpr size_t OFF_WD = OFF_WGU + (size_t)2 * FF * DM * 2;
constexpr size_t OFF_XB = OFF_WD + (size_t)DM * FF * 2;
constexpr size_t OFF_PROJ = OFF_XB + (size_t)MTOT * DM * 2;
constexpr size_t OFF_KGT = OFF_PROJ + (size_t)MTOT * PLD * 2;
constexpr size_t OFF_QK = OFF_KGT + (size_t)NITEM * 8192 * 2;
constexpr size_t OFF_VT = OFF_QK + (size_t)NITEM * 4096 * 2;
constexpr size_t OFF_H1B = OFF_KGT;
constexpr size_t WS_NEED = OFF_VT + (size_t)NBH * 128 * LTOT * 2;
static_assert((size_t)MREAL * DM * 2 <= WS_NEED - OFF_KGT, "H1B overlay");
constexpr size_t DN_BYTES = (size_t)NBH * LTOT * 128 * 2;
static_assert(3 * DN_BYTES <= (size_t)MREAL * DM * 4, "DN scratch in d_out");

struct Params {
    const float *x, *meta, *attn_norm_w, *w_in, *q_norm_w, *k_norm_w, *lq1, *lk1, *lq2, *lk2, *subln_w, *conv_w, *a_log, *dt_bias, *o_norm_w, *w_out, *ffn_norm_w, *w_gate, *w_up, *w_down;
    float* out; unsigned char* ws;
};
struct Ptrs {
    unsigned* ctl; float *rstd1, *ss2, *egl, *BA; bf16_t *WinT, *WoutT, *WguT, *WdT, *XB, *OCAT, *PROJ, *HID, *KGT, *QK, *VT, *H1B, *UT, *W, *QG;
};

DI float wave_sum(float v) {
#pragma unroll
    for (int o = 1; o < 64; o <<= 1) v += __shfl_xor(v, o);
    return v;
}
DI float bflo(unsigned u) { return __uint_as_float(u << 16); }
DI float bfhi(unsigned u) { return __uint_as_float(u & 0xffff0000u); }
DI bf16x8 ld16(const lds_u8* p) { return *(const LAS bf16x8*)p; }
DI f32x4 mfma16(bf16x8 a, bf16x8 b, f32x4 c) { return __builtin_amdgcn_mfma_f32_16x16x32_bf16(a, b, c, 0, 0, 0); }
DI f32x16 mfma32(bf16x8 a, bf16x8 b, f32x16 c) { return __builtin_amdgcn_mfma_f32_32x32x16_bf16(a, b, c, 0, 0, 0); }
DI float pl32_max(float m) { auto rr = __builtin_amdgcn_permlane32_swap(__float_as_uint(m), __float_as_uint(m), false, false); return fmaxf(__uint_as_float(rr[0]), __uint_as_float(rr[1])); }
DI float pl32_sum(float m) { auto rr = __builtin_amdgcn_permlane32_swap(__float_as_uint(m), __float_as_uint(m), false, false); return __uint_as_float(rr[0]) + __uint_as_float(rr[1]); }
#define LDS_FENCE() asm volatile("s_waitcnt lgkmcnt(0)" ::: "memory")
#if PROBE == 20
#define LDS_BAR() __syncthreads()
#else
#define LDS_BAR() asm volatile("s_waitcnt lgkmcnt(0)\n\ts_barrier" ::: "memory")
#endif

#define XB_TMO      128
#define XB_XCNT(j)  (256  + 64 * (j))
#define XB_XSUB(j)  (1280 + 64 * (j))
#define XB_XGEN(j)  (2304 + 64 * (j))
#define XB_TOP      3328
#define XB_TOPGEN   3392
#define XCD_BAR_WORDS 3456
#define XB_SPIN_CAP (1u << 18)

__device__ __forceinline__ unsigned xb_ld(unsigned* p)              { return __hip_atomic_load(p, __ATOMIC_RELAXED, __HIP_MEMORY_SCOPE_AGENT); }
__device__ __forceinline__ unsigned xb_add(unsigned* p, unsigned v) { return __hip_atomic_fetch_add(p, v, __ATOMIC_RELAXED, __HIP_MEMORY_SCOPE_AGENT); }
__device__ __forceinline__ unsigned xb_xcc_id() { return (unsigned)__builtin_amdgcn_s_getreg((3 << 11) | 20) & 0xFu; }
#define XB_SPIN(cond, bar) do { unsigned _sp = 0; while (cond) { __builtin_amdgcn_s_sleep(1); \
    if ((++_sp & 255u) == 0u) { if (xb_ld(&(bar)[XB_TMO])) break; if (_sp > XB_SPIN_CAP) { atomicAdd(&(bar)[XB_TMO], 1u); break; } } } } while (0)

struct XcdBarrier {
    unsigned* bar; unsigned x;
    volatile LAS unsigned* st;
};

__device__ __forceinline__ XcdBarrier xcd_barrier_post(unsigned* bar, volatile LAS unsigned* st) {
    XcdBarrier b; b.bar = bar; b.x = xb_xcc_id(); b.st = st;
    if (threadIdx.x == 0) (void)xb_add(&bar[XB_XCNT(b.x)], 1u);
    return b;
}
__device__ __forceinline__ void xcd_barrier_complete(unsigned* bar, unsigned x, unsigned& nloc, unsigned& nx) {
    const unsigned G = gridDim.x * gridDim.y * gridDim.z;
    unsigned sum, cnt, mine, sp = 0u;
    for (;;) {
        sum = 0u; cnt = 0u; mine = 0u;
#pragma unroll
        for (unsigned j = 0; j < 16; ++j) { const unsigned c = xb_ld(&bar[XB_XCNT(j)]); sum += c; cnt += (c > 0u) ? 1u : 0u; mine = (j == x) ? c : mine; }
        if (sum == G) break;
        __builtin_amdgcn_s_sleep(1);
        if ((++sp & 255u) == 0u) { if (xb_ld(&bar[XB_TMO])) break; if (sp > XB_SPIN_CAP) { atomicAdd(&bar[XB_TMO], 1u); break; } }
    }
    nloc = mine > 0u ? mine : 1u; nx = cnt > 0u ? cnt : 1u;
}

__device__ __forceinline__ void xcd_barrier(const XcdBarrier& b) {
    asm volatile("s_waitcnt vmcnt(0)" ::: "memory");
    __syncthreads();
    if (threadIdx.x == 0) {
        unsigned* bar = b.bar;
        __builtin_amdgcn_s_waitcnt(0);
        unsigned nloc = b.st[0], nx = b.st[1];
        if (nloc == 0u) { xcd_barrier_complete(bar, b.x, nloc, nx); b.st[0] = nloc; b.st[1] = nx; }
        const unsigned old = xb_add(&bar[XB_XSUB(b.x)], 1u);
        const unsigned gen = old / nloc;
        if (old + 1u == (gen + 1u) * nloc) {
            __builtin_amdgcn_fence(__ATOMIC_RELEASE, "agent");
            asm volatile("s_waitcnt vmcnt(0)" ::: "memory");
            const unsigned og = xb_add(&bar[XB_TOP], 1u);
            const unsigned tg = og / nx;
            if (og + 1u == (tg + 1u) * nx) xb_add(&bar[XB_TOPGEN], 1u);
            else XB_SPIN(xb_ld(&bar[XB_TOPGEN]) == tg, bar);
            __builtin_amdgcn_fence(__ATOMIC_ACQUIRE, "agent");
            xb_add(&bar[XB_XGEN(b.x)], 1u);
            asm volatile("s_waitcnt vmcnt(0)" ::: "memory");
        } else {
            XB_SPIN(xb_ld(&bar[XB_XGEN(b.x)]) == gen, bar);
            __builtin_amdgcn_fence(__ATOMIC_ACQUIRE, "agent");
            asm volatile("s_waitcnt vmcnt(0)" ::: "memory");
        }
    }
    __syncthreads();
}

template <int MODE>
DI void transpose_item(const float* W, int K, int N, int nblk, bf16_t* WT, const float* sc, LAS float* scr, int item, int lane) {
    const int kb = item / nblk, nb = item % nblk, k0 = 64 * kb, n0 = 32 * nb;
    const int l8 = lane & 7, kr = lane >> 3, n = n0 + 4 * l8;
    f32x4 v[8];
#pragma unroll
    for (int i = 0; i < 8; ++i) v[i] = (n < N) ? *(const f32x4*)(W + (size_t)(k0 + 8 * i + kr) * N + n) : (f32x4){0.f, 0.f, 0.f, 0.f};
#pragma unroll
    for (int i = 0; i < 8; ++i) { const int kk = 8 * i + kr; const float s_ = sc ? sc[k0 + kk] : 1.0f; LAS float* d = scr + kk * 33 + 4 * l8;
        d[0] = v[i][0] * s_; d[1] = v[i][1] * s_; d[2] = v[i][2] * s_; d[3] = v[i][3] * s_; }
    LDS_FENCE();
    const int c = lane & 7;
#pragma unroll
    for (int j = 0; j < 4; ++j) { const int nn = (lane >> 3) + 8 * j; const LAS float* s = scr + (8 * c) * 33 + nn;
        u32x4 o; o.x = pk2(s[0 * 33], s[1 * 33]); o.y = pk2(s[2 * 33], s[3 * 33]); o.z = pk2(s[4 * 33], s[5 * 33]); o.w = pk2(s[6 * 33], s[7 * 33]);
        const int ng = n0 + nn; const int row = MODE == 0 ? ng : (MODE == 1 ? ((ng >> 7) * 256 + (ng & 127)) : ((ng >> 7) * 256 + 128 + (ng & 127)));
        *(u32x4*)(WT + (size_t)row * K + k0 + 8 * c) = o; }
    LDS_FENCE();
}
DI void p0_prologue(const Params& p, const Ptrs& q, lds_u8* lds, int tid) {
    const int lane = tid & 63, wave = tid >> 6;
    const int gw = blockIdx.x * NWAVES + wave, NGW = gridDim.x * NWAVES;
    LAS float* scr = (LAS float*)(lds + wave * 16384);
    constexpr int I_IN = (DM / 64) * (INPAD / 32), I_OUT = (DM / 64) * (DM / 32), I_G = (DM / 64) * (FF / 32), I_D = (FF / 64) * (DM / 32);
    constexpr int NIT = I_IN + I_OUT + 2 * I_G + I_D;
    for (int it = gw; it < NIT; it += NGW) {
        int r = it;
        if (r < I_IN) { transpose_item<0>(p.w_in, DM, INCOLS, INPAD / 32, q.WinT, p.attn_norm_w, scr, r, lane); continue; } r -= I_IN;
        if (r < I_OUT) { transpose_item<0>(p.w_out, DM, DM, DM / 32, q.WoutT, nullptr, scr, r, lane); continue; } r -= I_OUT;
        if (r < I_G) { transpose_item<1>(p.w_gate, DM, FF, FF / 32, q.WguT, p.ffn_norm_w, scr, r, lane); continue; } r -= I_G;
        if (r < I_G) { transpose_item<2>(p.w_up, DM, FF, FF / 32, q.WguT, p.ffn_norm_w, scr, r, lane); continue; } r -= I_G;
        transpose_item<0>(p.w_down, FF, DM, DM / 32, q.WdT, nullptr, scr, r, lane);
    }
    for (int r = gw; r < MTOT; r += NGW) {
        const int b = r / LTOT, t = r - b * LTOT;
        const float* src = nullptr;
        if (t >= LEAD) src = p.x + ((size_t)b * SEQ + (t - LEAD)) * DM; else if (t >= NPAD) src = p.meta + (size_t)(t - NPAD) * DM;
        f32x4 v[8]; float ss = 0.f;
#pragma unroll
        for (int j = 0; j < 8; ++j) { v[j] = src ? ((const f32x4*)src)[64 * j + lane] : (f32x4){0.f, 0.f, 0.f, 0.f}; ss += (v[j][0] * v[j][0] + v[j][1] * v[j][1]) + (v[j][2] * v[j][2] + v[j][3] * v[j][3]); }
        ss = wave_sum(ss);
        if (lane == 0) q.rstd1[r] = rsqrtf(ss * (1.0f / DM) + EPS);
        u32x2* o = (u32x2*)(q.XB + (size_t)r * DM);
#pragma unroll
        for (int j = 0; j < 8; ++j) { u32x2 w; w.x = pk2(v[j][0], v[j][1]); w.y = pk2(v[j][2], v[j][3]); o[64 * j + lane] = w; }
    }
    for (int i = blockIdx.x * NTHR + tid; i < MREAL; i += gridDim.x * NTHR) q.ss2[i] = 0.f;
    if (blockIdx.x == 0 && tid < 64) q.ctl[tid] = 0u;
    if (blockIdx.x == 0) { unsigned* bar = (unsigned*)((unsigned char*)q.ctl + OFF_BAR); for (int i = tid; i < XCD_BAR_WORDS; i += NTHR) bar[i] = 0u; }
}

DI void qknorm_row(const Params& p, const Ptrs& q, int r, int lane) {
    bf16_t* row = q.PROJ + (size_t)r * PLD;
    u32x4 raw[4]; f32x4 w0[4], w1[4];
#pragma unroll
    for (int j = 0; j < 4; ++j) { const int col = j * 512 + lane * 8; raw[j] = *(const u32x4*)(row + col);
        const float* w = (j < 2 ? p.q_norm_w : p.k_norm_w) + (col & 63); w0[j] = *(const f32x4*)w; w1[j] = *(const f32x4*)(w + 4); }
#pragma unroll
    for (int j = 0; j < 4; ++j) {
        const int col = j * 512 + lane * 8;
        float v[8] = {bflo(raw[j].x), bfhi(raw[j].x), bflo(raw[j].y), bfhi(raw[j].y), bflo(raw[j].z), bfhi(raw[j].z), bflo(raw[j].w), bfhi(raw[j].w)};
        float ss = 0.f;
#pragma unroll
        for (int e = 0; e < 8; ++e) ss += v[e] * v[e];
        ss += __shfl_xor(ss, 1); ss += __shfl_xor(ss, 2); ss += __shfl_xor(ss, 4);
        float rs = rsqrtf(ss * (1.0f / 64.0f) + EPS);
        if (j < 2) rs *= 0.125f * LOG2E;
        u32x4 o; o.x = pk2(v[0] * rs * w0[j][0], v[1] * rs * w0[j][1]); o.y = pk2(v[2] * rs * w0[j][2], v[3] * rs * w0[j][3]); o.z = pk2(v[4] * rs * w1[j][0], v[5] * rs * w1[j][1]); o.w = pk2(v[6] * rs * w1[j][2], v[7] * rs * w1[j][3]);
        *(u32x4*)(row + col) = o;
    }
}
DI void vt_item(const Ptrs& q, lds_u8* scr, int item, int lane) {
    const int bh = item / NCH, tb = item - bh * NCH, b = bh >> 3, h = bh & 7;
    const bf16_t* src = q.PROJ + ((size_t)b * LTOT + 64 * tb) * PLD + 2048 + h * 128;
#pragma unroll 4
    for (int i = 0; i < 16; ++i) { const int tok = 4 * i + (lane >> 4), ch = lane & 15; *(LAS u32x4*)(scr + tok * 272 + ch * 16) = *(const u32x4*)(src + (size_t)tok * PLD + ch * 8); }
    LDS_FENCE();
    bf16_t* dst = q.VT + ((size_t)bh * 128) * LTOT + 64 * tb;
#pragma unroll 4
    for (int i = 0; i < 16; ++i) { const int v = 8 * i + (lane >> 3), c8 = lane & 7; unsigned e[8];
#pragma unroll
        for (int k = 0; k < 8; ++k) e[k] = *(const LAS unsigned short*)(scr + (16 * (c8 >> 1) + 4 * (2 * (k >> 2) + (c8 & 1)) + (k & 3)) * 272 + v * 2);
        u32x4 o; o.x = e[0] | (e[1] << 16); o.y = e[2] | (e[3] << 16); o.z = e[4] | (e[5] << 16); o.w = e[6] | (e[7] << 16);
        *(u32x4*)(dst + (size_t)v * LTOT + c8 * 8) = o; }
    LDS_FENCE();
}
template <int J, int QLO, int QHI> DI void t_load(f32x4 (&tq)[16], unsigned tb) {
    constexpr int lo = QLO > ((J + 1) >> 2) ? QLO : ((J + 1) >> 2);
#pragma unroll
    for (int q = lo; q < QHI; ++q) tq[q] = *(const LAS f32x4*)(uintptr_t)(tb + (J * 64 + 4 * q) * 4);
}
template <int J, int QLO, int QHI> DI void t_apply(float (&x)[64], const f32x4 (&tq)[16]) {
    const float xj = x[J];
#pragma unroll
    for (int q = QLO; q < QHI; ++q) { const f32x4 tv = tq[q]; const int i4 = 4 * q;
        if (i4 + 0 > J) x[i4 + 0] -= tv[0] * xj; if (i4 + 1 > J) x[i4 + 1] -= tv[1] * xj; if (i4 + 2 > J) x[i4 + 2] -= tv[2] * xj; if (i4 + 3 > J) x[i4 + 3] -= tv[3] * xj; }
}
template <int J> DI void solve_step(float (&x)[64], f32x4 (&tq)[16], unsigned tb) {
    constexpr int qs = (J + 1) >> 2, mid = (qs + 17) >> 1;
    t_apply<J, qs, mid>(x, tq);
    if constexpr (J + 1 < 63) t_load<J + 1, qs, mid>(tq, tb);
    t_apply<J, mid, 16>(x, tq);
    if constexpr (J + 1 < 63) t_load<J + 1, mid, 16>(tq, tb);
}
template <int... Js> DI void solve_all(float (&x)[64], f32x4 (&tq)[16], unsigned tb, std::integer_sequence<int, Js...>) { (solve_step<Js>(x, tq, tb), ...); }
DI void dn_prep_item(const Params& p, const Ptrs& q, lds_u8* lds, int item, int tid) {
    const int bh = item / NCH, n = item - bh * NCH, b = bh >> 3, h = bh & 7;
    const int lane = tid & 63, w = tid >> 6;
    LAS float* RHS1 = (LAS float*)(lds);
    LAS float* RHS2 = (LAS float*)(lds + 32768);
    lds_u8* KN = lds + 65536;
    lds_u8* QN = lds + 65536 + 17408;
    LAS float* T = (LAS float*)(lds + 100352);
    lds_u8* KGTs = lds + 116736;
    LAS float* GC = (LAS float*)(lds + 135168);
    LAS float* BETA = GC + 64;
    if (tid < 64) {
        const int t = 64 * n + tid; const size_t R = (size_t)b * LTOT + t;
        const float bv = q.BA[R * 16 + h], av = q.BA[R * 16 + 8 + h];
        const bool valid = t >= NPAD;
        const float beta = valid ? 1.0f / (1.0f + expf(-bv)) : 0.f;
        const float xs = av + p.dt_bias[h];
        const float sp = fmaxf(xs, 0.f) + log1pf(expf(-fabsf(xs)));
        const float g = valid ? -expf(p.a_log[h]) * sp : 0.f;
        float c = g;
#pragma unroll
        for (int o = 1; o < 64; o <<= 1) { const float y = __shfl_up(c, o); if (tid >= o) c += y; }
        GC[tid] = c; BETA[tid] = beta;
        if (tid == 63) q.egl[item] = expf(c);
    }
    LDS_BAR();
    {
        const float glast = GC[63];
        const int rr = tid >> 4, ch = tid & 15;
#pragma unroll
        for (int mi = 0; mi < 3; ++mi) { const int mat = 2 - mi;
            const int cc = mat * 1024 + h * 128 + ch * 8;
            f32x4 cw[8];
#pragma unroll
            for (int e = 0; e < 8; ++e) cw[e] = *(const f32x4*)(p.conv_w + (size_t)(cc + e) * 4);
#pragma unroll
            for (int half = 0; half < 2; ++half) {
                const int i = rr + 32 * half, t = 64 * n + i;
                const float gci = GC[i], bi = BETA[i];
                const bf16_t* src = q.PROJ + ((size_t)b * LTOT + t) * PLD + 3072 + cc;
                float a[8] = {0.f, 0.f, 0.f, 0.f, 0.f, 0.f, 0.f, 0.f};
#pragma unroll
                for (int j = 0; j < 4; ++j) { if (t - 3 + j >= 0) { const u32x4 raw = *(const u32x4*)(src - (ptrdiff_t)(3 - j) * PLD);
                        const float xv[8] = {bflo(raw.x), bfhi(raw.x), bflo(raw.y), bfhi(raw.y), bflo(raw.z), bfhi(raw.z), bflo(raw.w), bfhi(raw.w)};
#pragma unroll
                        for (int e = 0; e < 8; ++e) a[e] += xv[e] * cw[e][j]; } }
                float ss = 0.f;
#pragma unroll
                for (int e = 0; e < 8; ++e) { a[e] = silu_f(a[e]); ss += a[e] * a[e]; }
                if (mat < 2) { ss += __shfl_xor(ss, 1); ss += __shfl_xor(ss, 2); ss += __shfl_xor(ss, 4); ss += __shfl_xor(ss, 8); }
                if (mat == 0) {
                    const float sc = rsqrtf(ss + EPS) * 0.08838834764831845f, eg = expf(gci);
                    f32x4 y0, y1;
#pragma unroll
                    for (int e = 0; e < 4; ++e) { y0[e] = a[e] * sc; y1[e] = a[4 + e] * sc; }
                    *(LAS u32x4*)(QN + i * 272 + ch * 16) = pk8(y0, y1);
                    *(u32x4*)(q.QG + ((size_t)bh * LTOT + t) * 128 + ch * 8) = pk8(y0 * eg, y1 * eg);
                } else if (mat == 1) {
                    const float sc = rsqrtf(ss + EPS), f2 = bi * expf(gci), f3 = expf(glast - gci);
                    f32x4 y0, y1;
#pragma unroll
                    for (int e = 0; e < 4; ++e) { y0[e] = a[e] * sc; y1[e] = a[4 + e] * sc; }
                    *(LAS u32x4*)(KN + i * 272 + ch * 16) = pk8(y0, y1);
                    *(LAS f32x4*)(RHS2 + i * 128 + ch * 8) = y0 * f2; *(LAS f32x4*)(RHS2 + i * 128 + ch * 8 + 4) = y1 * f2;
#pragma unroll
                    for (int e = 0; e < 4; ++e) { *(LAS unsigned short*)(KGTs + (ch * 8 + e) * 144 + i * 2) = (unsigned short)(pk2(y0[e] * f3, 0.f) & 0xffffu);
                                                  *(LAS unsigned short*)(KGTs + (ch * 8 + 4 + e) * 144 + i * 2) = (unsigned short)(pk2(y1[e] * f3, 0.f) & 0xffffu); }
                } else {
                    f32x4 y0, y1;
#pragma unroll
                    for (int e = 0; e < 4; ++e) { y0[e] = a[e] * bi; y1[e] = a[4 + e] * bi; }
                    *(LAS f32x4*)(RHS1 + i * 128 + ch * 8) = y0; *(LAS f32x4*)(RHS1 + i * 128 + ch * 8 + 4) = y1;
                }
            }
        }
    }
    LDS_BAR();
    {
#pragma unroll
        for (int it = 0; it < 2; ++it) { const int idx = tid + NTHR * it, row = idx >> 3, c8 = idx & 7;
            *(u32x4*)(q.KGT + ((size_t)item * 128 + row) * 64 + c8 * 8) = *(const LAS u32x4*)(KGTs + row * 144 + c8 * 16); }
        const int r = lane & 15, qd = lane >> 4, mt = w >> 1;
#pragma unroll
        for (int nn = 0; nn < 2; ++nn) {
            const int nt = 2 * (w & 1) + nn;
            bf16_t* qkg = q.QK + (size_t)item * 4096;
            if (nt > mt) {
#pragma unroll
                for (int i = 0; i < 4; ++i) qkg[(16 * mt + 4 * qd + i) * 64 + 16 * nt + r] = 0;
                continue;
            }
            f32x4 kk = {0.f, 0.f, 0.f, 0.f}, qk = {0.f, 0.f, 0.f, 0.f};
#pragma unroll
            for (int ks = 0; ks < 4; ++ks) {
                const bf16x8 bk = ld16(KN + (16 * nt + r) * 272 + (32 * ks + 8 * qd) * 2);
                const bf16x8 ak = ld16(KN + (16 * mt + r) * 272 + (32 * ks + 8 * qd) * 2);
                const bf16x8 aq = ld16(QN + (16 * mt + r) * 272 + (32 * ks + 8 * qd) * 2);
                kk = mfma16(ak, bk, kk); qk = mfma16(aq, bk, qk);
            }
            const int jj = 16 * nt + r; const float gcj = GC[jj];
#pragma unroll
            for (int i = 0; i < 4; ++i) { const int ii = 16 * mt + 4 * qd + i; const float dec = expf(fminf(GC[ii] - gcj, 0.f));
                T[jj * 64 + ii] = (jj < ii) ? BETA[ii] * kk[i] * dec : 0.f;
                qkg[ii * 64 + jj] = (unsigned short)(pk2((jj <= ii) ? qk[i] * dec : 0.f, 0.f) & 0xffffu); }
        }
    }
    LDS_BAR();
    if (tid < 256) {
        const int c = tid & 127; const bool isw = tid >= 128;
        const LAS float* rhs = isw ? RHS2 : RHS1;
        unsigned tb = (unsigned)(uintptr_t)T; asm volatile("" : "+v"(tb));
        float x[64];
#pragma unroll
        for (int i = 0; i < 64; ++i) x[i] = rhs[i * 128 + c];
        f32x4 tq[16];
        t_load<0, 0, 16>(tq, tb);
        solve_all(x, tq, tb, std::make_integer_sequence<int, 63>{});
        if (!isw) {
            bf16_t* d = q.UT + ((size_t)item * 128 + c) * 64;
#pragma unroll
            for (int i = 0; i < 64; i += 8) { u32x4 o; o.x = pk2(x[i], x[i + 1]); o.y = pk2(x[i + 2], x[i + 3]); o.z = pk2(x[i + 4], x[i + 5]); o.w = pk2(x[i + 6], x[i + 7]); *(u32x4*)(d + i) = o; }
        } else {
            bf16_t* d = q.W + ((size_t)bh * LTOT + 64 * n) * 128 + c;
#pragma unroll
            for (int i = 0; i < 64; ++i) d[(size_t)i * 128] = (unsigned short)(pk2(x[i], 0.f) & 0xffffu);
        }
    }
    LDS_BAR();
}

DI void dn_prep_phase(const Params& p, const Ptrs& q, lds_u8* lds, int tid, int G) {
    const int lane = tid & 63, w = __builtin_amdgcn_readfirstlane(tid >> 6);
    LAS float* RHS1 = (LAS float*)(lds);
    LAS float* RHS2 = (LAS float*)(lds + 32768);
    lds_u8* KN = lds + 65536;
    lds_u8* QN = lds + 65536 + 17408;
    LAS float* T = (LAS float*)(lds + 100352);
    lds_u8* KGTs = lds + 116736;
    LAS float* GCW = (LAS float*)(lds + 135168);
    float x[64];
#pragma unroll
    for (int i = 0; i < 64; ++i) x[i] = 0.f;
    unsigned tb = (unsigned)(uintptr_t)T; asm volatile("" : "+v"(tb));
    int prev = -1;
    int qrow = (int)blockIdx.x * 4 + w;
    float bvn = 0.f, avn = 0.f;
    if (w >= 4) { const int it0 = blockIdx.x, bh = it0 / NCH, n = it0 - bh * NCH; const size_t R = (size_t)(bh >> 3) * LTOT + 64 * n + lane; bvn = q.BA[R * 16 + (bh & 7)]; avn = q.BA[R * 16 + 8 + (bh & 7)]; }
#pragma unroll 1
    for (int it = blockIdx.x;; it += G) {
        const bool have = it < NITEM;
        if (w >= 4) {
            if (have) {
                const int bh = it / NCH, n = it - bh * NCH, b = bh >> 3, h = bh & 7, wp = w - 4;
                LAS float* GC = GCW + wp * 128; LAS float* BETA = GC + 64;
                {   const int t = 64 * n + lane;
                    const float bv = bvn, av = avn;
                    if (it + G < NITEM) { const int i2 = it + G, bh2 = i2 / NCH, n2 = i2 - bh2 * NCH; const size_t R2 = (size_t)(bh2 >> 3) * LTOT + 64 * n2 + lane; bvn = q.BA[R2 * 16 + (bh2 & 7)]; avn = q.BA[R2 * 16 + 8 + (bh2 & 7)]; }
                    const bool valid = t >= NPAD;
                    const float beta = valid ? 1.0f / (1.0f + expf(-bv)) : 0.f;
                    const float xs = av + p.dt_bias[h];
                    const float sp = fmaxf(xs, 0.f) + log1pf(expf(-fabsf(xs)));
                    const float g = valid ? -expf(p.a_log[h]) * sp : 0.f;
                    float c = g;
#pragma unroll
                    for (int o = 1; o < 64; o <<= 1) { const float y = __shfl_up(c, o); if (lane >= o) c += y; }
                    GC[lane] = c; BETA[lane] = beta;
                    if (wp == 0 && lane == 63) q.egl[it] = expf(c);
                }
                LDS_FENCE();
                const float glast = GC[63];
                const int tq_ = tid - 256, rr = tq_ >> 4, ch = tq_ & 15;
#pragma unroll 1
                for (int mi = 0; mi < 3; ++mi) { const int mat = 2 - mi;
                    const int cc = mat * 1024 + h * 128 + ch * 8;
                    f32x4 cw[8];
#pragma unroll
                    for (int e = 0; e < 8; ++e) cw[e] = *(const f32x4*)(p.conv_w + (size_t)(cc + e) * 4);
#pragma unroll
                  for (int qp = 0; qp < 1; ++qp) {
                    u32x4 raw[4][4];
#pragma unroll
                    for (int q2 = 0; q2 < 4; ++q2) { const int t = 64 * n + rr + 16 * q2; const bf16_t* src = q.PROJ + ((size_t)b * LTOT + t) * PLD + 3072 + cc;
#pragma unroll
                        for (int j = 0; j < 4; ++j) raw[q2][j] = (t - 3 + j >= 0) ? *(const u32x4*)(src - (ptrdiff_t)(3 - j) * PLD) : (u32x4){0u, 0u, 0u, 0u}; }
#pragma unroll
                    for (int q2 = 0; q2 < 4; ++q2) { const int qr = q2;
                        const int i = rr + 16 * qr, t = 64 * n + i;
                        const float gci = GC[i], bi = BETA[i];
                        float a[8] = {0.f, 0.f, 0.f, 0.f, 0.f, 0.f, 0.f, 0.f};
#pragma unroll
                        for (int j = 0; j < 4; ++j) { const u32x4 rw = raw[q2][j];
                            const float xv[8] = {bflo(rw.x), bfhi(rw.x), bflo(rw.y), bfhi(rw.y), bflo(rw.z), bfhi(rw.z), bflo(rw.w), bfhi(rw.w)};
#pragma unroll
                            for (int e = 0; e < 8; ++e) a[e] += xv[e] * cw[e][j]; }
                        float ss = 0.f;
#pragma unroll
                        for (int e = 0; e < 8; ++e) { a[e] = silu_f(a[e]); ss += a[e] * a[e]; }
                        if (mat < 2) { ss += __shfl_xor(ss, 1); ss += __shfl_xor(ss, 2); ss += __shfl_xor(ss, 4); ss += __shfl_xor(ss, 8); }
                        if (mat == 0) {
                            const float sc = rsqrtf(ss + EPS) * 0.08838834764831845f, eg = expf(gci);
                            f32x4 y0, y1;
#pragma unroll
                            for (int e = 0; e < 4; ++e) { y0[e] = a[e] * sc; y1[e] = a[4 + e] * sc; }
                            *(LAS u32x4*)(QN + i * 272 + ch * 16) = pk8(y0, y1);
                            *(u32x4*)(q.QG + ((size_t)bh * LTOT + t) * 128 + ch * 8) = pk8(y0 * eg, y1 * eg);
                        } else if (mat == 1) {
                            const float sc = rsqrtf(ss + EPS), f2 = bi * expf(gci), f3 = expf(glast - gci);
                            f32x4 y0, y1;
#pragma unroll
                            for (int e = 0; e < 4; ++e) { y0[e] = a[e] * sc; y1[e] = a[4 + e] * sc; }
                            *(LAS u32x4*)(KN + i * 272 + ch * 16) = pk8(y0, y1);
                            *(LAS f32x4*)(RHS2 + i * 128 + ch * 8) = y0 * f2; *(LAS f32x4*)(RHS2 + i * 128 + ch * 8 + 4) = y1 * f2;
#pragma unroll
                            for (int e = 0; e < 4; ++e) { *(LAS unsigned short*)(KGTs + (ch * 8 + e) * 144 + i * 2) = (unsigned short)(pk2(y0[e] * f3, 0.f) & 0xffffu);
                                                          *(LAS unsigned short*)(KGTs + (ch * 8 + 4 + e) * 144 + i * 2) = (unsigned short)(pk2(y1[e] * f3, 0.f) & 0xffffu); }
                        } else {
                            f32x4 y0, y1;
#pragma unroll
                            for (int e = 0; e < 4; ++e) { y0[e] = a[e] * bi; y1[e] = a[4 + e] * bi; }
                            *(LAS f32x4*)(RHS1 + i * 128 + ch * 8) = y0; *(LAS f32x4*)(RHS1 + i * 128 + ch * 8 + 4) = y1;
                        }
                    }
                  }
                }
            }
        } else { if (prev >= 0) {
            const int bh = prev / NCH, n = prev - bh * NCH;
            const int c = tid & 127; const bool isw = tid >= 128;
            f32x4 tq[16];
            t_load<0, 0, 16>(tq, tb);
            solve_all(x, tq, tb, std::make_integer_sequence<int, 63>{});
            if (!isw) {
                bf16_t* d = q.UT + ((size_t)prev * 128 + c) * 64;
#pragma unroll
                for (int i = 0; i < 64; i += 8) { u32x4 o; o.x = pk2(x[i], x[i + 1]); o.y = pk2(x[i + 2], x[i + 3]); o.z = pk2(x[i + 4], x[i + 5]); o.w = pk2(x[i + 6], x[i + 7]); *(u32x4*)(d + i) = o; }
            } else {
                bf16_t* d = q.W + ((size_t)bh * LTOT + 64 * n) * 128 + c;
#pragma unroll
                for (int i = 0; i < 64; ++i) d[(size_t)i * 128] = (unsigned short)(pk2(x[i], 0.f) & 0xffffu);
            } }
#pragma unroll 1
            for (int k2 = 0; k2 < 2; ++k2) { if (qrow < MTOT) qknorm_row(p, q, qrow, lane); qrow += 4 * G; }
        }
        if (!have) break;
        LDS_BAR();
        {
            const LAS float* GC = GCW; const LAS float* BETA = GCW + 64;
            int tl = tid; asm volatile("" : "+v"(tl));
            const int lane = tl & 63;
#pragma unroll
            for (int k2 = 0; k2 < 2; ++k2) { const int idx = tl + NTHR * k2, row = idx >> 3, c8 = idx & 7;
                *(u32x4*)(q.KGT + ((size_t)it * 128 + row) * 64 + c8 * 8) = *(const LAS u32x4*)(KGTs + row * 144 + c8 * 16); }
            const int r = lane & 15, qd = lane >> 4, mt = w >> 1;
#pragma unroll
            for (int nn = 0; nn < 2; ++nn) {
                const int nt = 2 * (w & 1) + nn;
                bf16_t* qkg = q.QK + (size_t)it * 4096;
                if (nt > mt) {
#pragma unroll
                    for (int i = 0; i < 4; ++i) qkg[(16 * mt + 4 * qd + i) * 64 + 16 * nt + r] = 0;
                    continue;
                }
                f32x4 kk = {0.f, 0.f, 0.f, 0.f}, qk = {0.f, 0.f, 0.f, 0.f};
#pragma unroll
                for (int ks = 0; ks < 4; ++ks) {
                    const bf16x8 bk = ld16(KN + (16 * nt + r) * 272 + (32 * ks + 8 * qd) * 2);
                    const bf16x8 ak = ld16(KN + (16 * mt + r) * 272 + (32 * ks + 8 * qd) * 2);
                    const bf16x8 aq = ld16(QN + (16 * mt + r) * 272 + (32 * ks + 8 * qd) * 2);
                    kk = mfma16(ak, bk, kk); qk = mfma16(aq, bk, qk);
                }
                const int jj = 16 * nt + r; const float gcj = GC[jj];
#pragma unroll
                for (int i = 0; i < 4; ++i) { const int ii = 16 * mt + 4 * qd + i; const float dec = expf(fminf(GC[ii] - gcj, 0.f));
                    T[jj * 64 + ii] = (jj < ii) ? BETA[ii] * kk[i] * dec : 0.f;
                    qkg[ii * 64 + jj] = (unsigned short)(pk2((jj <= ii) ? qk[i] * dec : 0.f, 0.f) & 0xffffu); }
            }
        }
        LDS_BAR();
        if (w < 4) { int tl = tid; asm volatile("" : "+v"(tl)); const int c = tl & 127; const LAS float* rhs = (w >= 2) ? RHS2 : RHS1;
#pragma unroll
            for (int i = 0; i < 64; ++i) x[i] = rhs[i * 128 + c]; }
        LDS_BAR();
        prev = it;
    }
    if (w < 4) for (; qrow < MTOT; qrow += 4 * G) qknorm_row(p, q, qrow, lane);
}

DI void dn_scan(const Params& p, const Ptrs& q, lds_u8* lds, int bh, int tid) {
    const int lane = tid & 63, w = tid >> 6, r = lane & 15, qd = lane >> 4, ct = w >> 1, vh = w & 1, b = bh >> 3, h = bh & 7;
    lds_u8 *ST = lds, *Wt = lds + 34816, *QGt = lds + 52224, *UTt = lds + 69632, *KGTt = lds + 88064, *VNT = lds + 106496, *QKt = lds + 124928;
    LAS float* PS = (LAS float*)(lds + 134144);
    for (int i = tid; i < 34816 / 16; i += NTHR) *(LAS u32x4*)(ST + i * 16) = (u32x4){0u, 0u, 0u, 0u};
    f32x4 Sm[8];
#pragma unroll
    for (int k = 0; k < 8; ++k) Sm[k] = (f32x4){0.f, 0.f, 0.f, 0.f};
    u32x4 pw[2], pq[2], pu[2], pk[2], pqk;
#define DN_LOAD(nn) do { const size_t it_ = (size_t)bh * NCH + (nn); \
        const u32x4* gw_ = (const u32x4*)(q.W + ((size_t)bh * LTOT + 64 * (nn)) * 128); const u32x4* gq_ = (const u32x4*)(q.QG + ((size_t)bh * LTOT + 64 * (nn)) * 128); \
        const u32x4* gu_ = (const u32x4*)(q.UT + it_ * 8192); const u32x4* gk_ = (const u32x4*)(q.KGT + it_ * 8192); \
        pw[0] = gw_[tid]; pw[1] = gw_[tid + NTHR]; pq[0] = gq_[tid]; pq[1] = gq_[tid + NTHR]; pu[0] = gu_[tid]; pu[1] = gu_[tid + NTHR]; pk[0] = gk_[tid]; pk[1] = gk_[tid + NTHR]; \
        pqk = ((const u32x4*)(q.QK + it_ * 4096))[tid]; } while (0)
#define DN_STORE() do { _Pragma("unroll") for (int it_ = 0; it_ < 2; ++it_) { const int idx_ = tid + NTHR * it_; \
        *(LAS u32x4*)(Wt + (idx_ >> 4) * 272 + (idx_ & 15) * 16) = pw[it_]; *(LAS u32x4*)(QGt + (idx_ >> 4) * 272 + (idx_ & 15) * 16) = pq[it_]; \
        *(LAS u32x4*)(UTt + (idx_ >> 3) * 144 + (idx_ & 7) * 16) = pu[it_]; *(LAS u32x4*)(KGTt + (idx_ >> 3) * 144 + (idx_ & 7) * 16) = pk[it_]; } \
        *(LAS u32x4*)(QKt + (tid >> 3) * 144 + (tid & 7) * 16) = pqk; } while (0)
    f32x4 oww[4];
#pragma unroll
    for (int j = 0; j < 4; ++j) oww[j] = *(const f32x4*)(p.o_norm_w + 64 * vh + 16 * j + 4 * qd);
    u32x2 zr[4];
#pragma unroll
    for (int j = 0; j < 4; ++j) zr[j] = (u32x2){0u, 0u};
    const bf16_t* zbase = q.PROJ + ((size_t)b * LTOT + 16 * ct + r) * PLD + 6144 + h * 128 + 64 * vh + 4 * qd;
    LAS float* EGs = (LAS float*)(lds + 134656);
    if (tid < NCH) EGs[tid] = q.egl[(size_t)bh * NCH + tid];
    DN_LOAD(1); DN_STORE();
    LDS_BAR();
    f32x4 a2p[4]; float rsp = 0.f;
#pragma unroll
    for (int j = 0; j < 4; ++j) a2p[j] = (f32x4){0.f, 0.f, 0.f, 0.f};
#define DN_EMIT(np_) do { const int tp_ = 64 * (np_) + 16 * ct + r; bf16_t* orow_ = q.OCAT + ((size_t)b * SEQ + (tp_ - LEAD)) * DM + 1024 + h * 128; \
        _Pragma("unroll") for (int j = 0; j < 4; ++j) { const int v0 = 64 * vh + 16 * j + 4 * qd; const f32x4 ow = oww[j]; \
            const float z0 = bflo(zr[j].x), z1 = bfhi(zr[j].x), z2 = bflo(zr[j].y), z3 = bfhi(zr[j].y); \
            u32x2 o; o.x = pk2(a2p[j][0] * rsp * ow[0] * silu_f(z0), a2p[j][1] * rsp * ow[1] * silu_f(z1)); o.y = pk2(a2p[j][2] * rsp * ow[2] * silu_f(z2), a2p[j][3] * rsp * ow[3] * silu_f(z3)); \
            *(u32x2*)(orow_ + v0) = o; } } while (0)
#pragma unroll 1
    for (int n = 1; n < NCH; ++n) {
        const float egl = EGs[n];
        if (n >= 3) DN_EMIT(n - 1);
#pragma unroll
        for (int j = 0; j < 4; ++j) zr[j] = *(const u32x2*)(zbase + (size_t)(64 * n) * PLD + 16 * j);
        if (n + 1 < NCH) DN_LOAD(n + 1);
        f32x4 a1[4], a2[4];
#pragma unroll
        for (int j = 0; j < 4; ++j) { a1[j] = (f32x4){0.f, 0.f, 0.f, 0.f}; a2[j] = (f32x4){0.f, 0.f, 0.f, 0.f}; }
#pragma unroll
        for (int ks = 0; ks < 4; ++ks) { const bf16x8 aw = ld16(Wt + (16 * ct + r) * 272 + (32 * ks + 8 * qd) * 2), bq = ld16(QGt + (16 * ct + r) * 272 + (32 * ks + 8 * qd) * 2);
#pragma unroll
            for (int j = 0; j < 4; ++j) { const bf16x8 st = ld16(ST + (64 * vh + 16 * j + r) * 272 + (32 * ks + 8 * qd) * 2);
                a1[j] = mfma16(aw, st, a1[j]);
                a2[j] = mfma16(st, bq, a2[j]); } }
#pragma unroll
        for (int j = 0; j < 4; ++j) { const int v = 64 * vh + 16 * j + r; const u32x2 uu = *(const LAS u32x2*)(UTt + v * 144 + (16 * ct + 4 * qd) * 2);
            u32x2 o; o.x = pk2(bflo(uu.x) - a1[j][0], bfhi(uu.x) - a1[j][1]); o.y = pk2(bflo(uu.y) - a1[j][2], bfhi(uu.y) - a1[j][3]);
            *(LAS u32x2*)(VNT + v * 144 + (16 * ct + 4 * qd) * 2) = o; }
        LDS_BAR();
#pragma unroll
        for (int ks = 0; ks < 2; ++ks) { const bf16x8 bb = ld16(QKt + (16 * ct + r) * 144 + (32 * ks + 8 * qd) * 2);
#pragma unroll
            for (int j = 0; j < 4; ++j) a2[j] = mfma16(ld16(VNT + (64 * vh + 16 * j + r) * 144 + (32 * ks + 8 * qd) * 2), bb, a2[j]); }
#pragma unroll
        for (int kt = 0; kt < 8; ++kt) Sm[kt] = Sm[kt] * egl;
#pragma unroll
        for (int ks = 0; ks < 2; ++ks) { const bf16x8 bb = ld16(VNT + (16 * w + r) * 144 + (32 * ks + 8 * qd) * 2);
#pragma unroll
            for (int kt = 0; kt < 8; ++kt) Sm[kt] = mfma16(ld16(KGTt + (16 * kt + r) * 144 + (32 * ks + 8 * qd) * 2), bb, Sm[kt]); }
        {   float ps = 0.f;
#pragma unroll
            for (int j = 0; j < 4; ++j) ps += (a2[j][0] * a2[j][0] + a2[j][1] * a2[j][1]) + (a2[j][2] * a2[j][2] + a2[j][3] * a2[j][3]);
            ps += __shfl_xor(ps, 16); ps += __shfl_xor(ps, 32);
            if (qd == 0) PS[(16 * ct + r) * 2 + vh] = ps; }
        LDS_BAR();
#pragma unroll
        for (int kt = 0; kt < 8; ++kt) { u32x2 o; o.x = pk2(Sm[kt][0], Sm[kt][1]); o.y = pk2(Sm[kt][2], Sm[kt][3]); *(LAS u32x2*)(ST + (16 * w + r) * 272 + (16 * kt + 4 * qd) * 2) = o; }
        if (n + 1 < NCH) DN_STORE();
        rsp = rsqrtf((PS[(16 * ct + r) * 2] + PS[(16 * ct + r) * 2 + 1]) * (1.0f / 128.0f) + EPS);
#pragma unroll
        for (int j = 0; j < 4; ++j) a2p[j] = a2[j];
        LDS_BAR();
    }
    DN_EMIT(NCH - 1);
#undef DN_EMIT
#undef DN_LOAD
#undef DN_STORE
}

DI int crow(int r, int hi) { return (r & 3) + 8 * (r >> 2) + 4 * hi; }
DI void attn_unit(const Params& p, const Ptrs& q, lds_u8* lds, int unit, int tid, float lam, float smax2) {
    const int lane = tid & 63, w = tid >> 6, r32 = lane & 31, hi = lane >> 5, mp = w & 1, sb = w >> 1;
    const int h = 7 - (unit >> 8), iq = 63 - ((unit & 255) >> 2), b = unit & 3, bh = b * 8 + h;
    const int q0 = LEAD + 128 * iq, qpos = q0 + 32 * sb + r32, ktl = 2 * iq + 3;
    const float c = exp2f(-(float)(h + 1)) * LOG2E;
    const int Dk = (int)((2.0f * smax2 + 152.0f) / c) + 2;
    const int klo = (q0 - Dk > 128) ? ((q0 - Dk) >> 6) : 2;
    bf16x8 qf[4];
    {   const bf16_t* qrow = q.PROJ + ((size_t)b * LTOT + qpos) * PLD + h * 128 + mp * 64 + hi * 8;
#pragma unroll
        for (int d0 = 0; d0 < 4; ++d0) qf[d0] = *(const bf16x8*)(qrow + d0 * 16); }
    f32x16 O[4];
#pragma unroll
    for (int vb = 0; vb < 4; ++vb)
#pragma unroll
        for (int e = 0; e < 16; ++e) O[vb][e] = 0.f;
    float l = 0.f;
    const bf16_t* kg = q.PROJ + ((size_t)b * LTOT) * PLD + 1024 + h * 128;
    const bf16_t* vg = q.VT + ((size_t)bh * 128) * LTOT;
    const int kkey = tid >> 3, kch = tid & 7, vv = tid >> 2, vch = tid & 3;
    u32x4 pk0A, pk1A, pv0A, pv1A, pk0B, pk1B, pv0B, pv1B;
#define AT_LOAD(S, kt_) do { const bf16_t* a_ = kg + (size_t)(64 * (kt_) + kkey) * PLD + kch * 8; pk0##S = *(const u32x4*)a_; pk1##S = *(const u32x4*)(a_ + 64); \
        const bf16_t* v_ = vg + (size_t)vv * LTOT + 64 * (kt_) + vch * 8; pv0##S = *(const u32x4*)v_; pv1##S = *(const u32x4*)(v_ + 32); } while (0)
#define AT_STORE(S, buf_) do { lds_u8* kb_ = lds + (buf_) * 17408 + kkey * 272 + kch * 16; *(LAS u32x4*)kb_ = pk0##S; *(LAS u32x4*)(kb_ + 128) = pk1##S; \
          \
        lds_u8* vb_ = lds + 34816 + (buf_) * 18432 + vv * 144 + vch * 16; *(LAS u32x4*)vb_ = pv0##S; *(LAS u32x4*)(vb_ + 64) = pv1##S; } while (0)
#define AT_NEXT(k_) (((k_) > klo) ? (k_) - 1 : ((k_) > 1 ? 1 : 0))
    AT_LOAD(A, ktl);
    { const int k1_ = AT_NEXT(ktl); if (k1_) AT_LOAD(B, k1_); }
    AT_STORE(A, 0);
    LDS_BAR();
    int kt = ktl; bool done = false;
#pragma unroll 1
    while (!done) {
#pragma unroll
      for (int cur = 0; cur < 2; ++cur) {
        const int knext = AT_NEXT(kt), knn = knext ? AT_NEXT(knext) : 0;
        if (knn) { if (cur) AT_LOAD(B, knn); else AT_LOAD(A, knn); }
        const lds_u8* Kb = lds + cur * 17408; const lds_u8* Vb = lds + 34816 + cur * 18432;
        const bool first = (kt == 1);
        const float ce = first ? 0.f : c;
        const float b0 = first ? 0.f : c * (float)(64 * kt + 4 * hi - qpos);
        f32x16 S0, S1;
#pragma unroll
        for (int e = 0; e < 16; ++e) { S0[e] = 0.f; S1[e] = 0.f; }
        bf16x8 kf0[4], kf1[4];
#pragma unroll
        for (int d0 = 0; d0 < 4; ++d0) { kf0[d0] = ld16(Kb + r32 * 272 + mp * 128 + d0 * 32 + hi * 16); kf1[d0] = ld16(Kb + (32 + r32) * 272 + mp * 128 + d0 * 32 + hi * 16); }
        __builtin_amdgcn_sched_barrier(0);
#pragma unroll
        for (int d0 = 0; d0 < 4; ++d0) { S0 = mfma32(kf0[d0], qf[d0], S0); S1 = mfma32(kf1[d0], qf[d0], S1); }
#define AT_VFRAG(g_) ld16(Vb + (32 * ((g_) >> 2) + r32) * 144 + (32 * (((g_) >> 1) & 1) + 16 * ((g_) & 1) + 8 * hi) * 2)
        bf16x8 vfa[8];
#pragma unroll
        for (int g = 0; g < 8; ++g) vfa[g] = AT_VFRAG(g);
        __builtin_amdgcn_sched_barrier(0);
#pragma unroll
        for (int e = 0; e < 16; ++e) { const float kr = (float)((e & 3) + 8 * (e >> 2)); S0[e] = fmaf(ce, kr, S0[e]); S1[e] = fmaf(ce, kr + 32.0f, S1[e]); }
        if (first) {
            asm volatile("");
#pragma unroll
            for (int e = 0; e < 16; ++e) { S0[e] = -INFINITY; if (e < 8) S1[e] = -INFINITY; }
        }
        if (kt >= ktl - 1) {
            asm volatile("");
            const int kb0 = 64 * kt + 4 * hi;
#pragma unroll
            for (int e = 0; e < 16; ++e) { const int key = kb0 + (e & 3) + 8 * (e >> 2); if (key > qpos) S0[e] = -INFINITY; if (key + 32 > qpos) S1[e] = -INFINITY; }
        }
        const float mb = smax2 - b0;
        float sum = 0.f;
#pragma unroll
        for (int e = 0; e < 16; ++e) { S0[e] = __builtin_amdgcn_exp2f(S0[e] - mb); S1[e] = __builtin_amdgcn_exp2f(S1[e] - mb); sum += S0[e] + S1[e]; }
        l += sum;
        bf16x8 pf[2][2];
#pragma unroll
        for (int ks = 0; ks < 2; ++ks) {
            u32x4 t0, t1;
            t0.x = pk2(S0[8 * ks + 0], S0[8 * ks + 1]); t0.y = pk2(S0[8 * ks + 2], S0[8 * ks + 3]); t0.z = pk2(S0[8 * ks + 4], S0[8 * ks + 5]); t0.w = pk2(S0[8 * ks + 6], S0[8 * ks + 7]);
            t1.x = pk2(S1[8 * ks + 0], S1[8 * ks + 1]); t1.y = pk2(S1[8 * ks + 2], S1[8 * ks + 3]); t1.z = pk2(S1[8 * ks + 4], S1[8 * ks + 5]); t1.w = pk2(S1[8 * ks + 6], S1[8 * ks + 7]);
            pf[0][ks] = __builtin_bit_cast(bf16x8, t0); pf[1][ks] = __builtin_bit_cast(bf16x8, t1);
        }
        __builtin_amdgcn_sched_barrier(0);
#pragma unroll
        for (int g = 0; g < 4; ++g) O[0] = mfma32(vfa[g], pf[(g >> 1) & 1][g & 1], O[0]);
#pragma unroll
        for (int g = 0; g < 4; ++g) vfa[g] = AT_VFRAG(8 + g);
        __builtin_amdgcn_sched_barrier(0);
#pragma unroll
        for (int g = 4; g < 8; ++g) O[1] = mfma32(vfa[g], pf[(g >> 1) & 1][g & 1], O[1]);
#pragma unroll
        for (int g = 4; g < 8; ++g) vfa[g] = AT_VFRAG(8 + g);
        __builtin_amdgcn_sched_barrier(0);
#pragma unroll
        for (int g = 0; g < 4; ++g) O[2] = mfma32(vfa[g], pf[(g >> 1) & 1][g & 1], O[2]);
#pragma unroll
        for (int g = 4; g < 8; ++g) O[3] = mfma32(vfa[g], pf[(g >> 1) & 1][g & 1], O[3]);
#undef AT_VFRAG
        if (knext) { if (cur) AT_STORE(A, 0); else AT_STORE(B, 1); }
        LDS_BAR();
        if (!knext) { done = true; break; }
        kt = knext;
      }
    }
#undef AT_NEXT
#undef AT_LOAD
#undef AT_STORE
    const float inv = 1.0f / pl32_sum(l);
    LAS float* comb = (LAS float*)lds + sb * 4096;
    if (mp == 1) {
#pragma unroll
        for (int vb = 0; vb < 4; ++vb)
#pragma unroll
            for (int e = 0; e < 16; ++e) comb[(32 * vb + crow(e, hi)) * 32 + r32] = O[vb][e] * inv;
    }
    LDS_BAR();
    if (mp == 0) {
        float ss = 0.f;
#pragma unroll
        for (int vb = 0; vb < 4; ++vb)
#pragma unroll
            for (int e = 0; e < 16; ++e) { const float o = O[vb][e] * inv - lam * comb[(32 * vb + crow(e, hi)) * 32 + r32]; O[vb][e] = o; ss += o * o; }
        ss = pl32_sum(ss);
        const float rs = rsqrtf(ss * (1.0f / 128.0f) + EPS) * 0.8f;
        bf16_t* orow = q.OCAT + ((size_t)b * SEQ + (qpos - LEAD)) * DM + h * 128;
        u32x2 ov[4][4];
#pragma unroll
        for (int vb = 0; vb < 4; ++vb)
#pragma unroll
            for (int g = 0; g < 4; ++g) { const int v0 = 32 * vb + 8 * g + 4 * hi; const f32x4 sw = *(const f32x4*)(p.subln_w + v0);
                ov[vb][g].x = pk2(O[vb][4 * g] * rs * sw[0], O[vb][4 * g + 1] * rs * sw[1]); ov[vb][g].y = pk2(O[vb][4 * g + 2] * rs * sw[2], O[vb][4 * g + 3] * rs * sw[3]); }
#pragma unroll
        for (int vb = 0; vb < 4; ++vb)
#pragma unroll
            for (int j = 0; j < 2; ++j) {
                const auto sx = __builtin_amdgcn_permlane32_swap(ov[vb][2 * j].x, ov[vb][2 * j + 1].x, false, false);
                const auto sy = __builtin_amdgcn_permlane32_swap(ov[vb][2 * j].y, ov[vb][2 * j + 1].y, false, false);
                const u32x4 w16 = {sx[0], sy[0], sx[1], sy[1]};
                *(u32x4*)(orow + 32 * vb + 8 * (2 * j + hi)) = w16;
            }
    }
    LDS_BAR();
}

DI void attn_unit2(const Params& p, const Ptrs& q, lds_u8* lds, int unit, int tid, float lam, float smax2) {
    const int lane = tid & 63, w = tid >> 6, r32 = lane & 31, hi = lane >> 5, mp = w & 1, sb = w >> 1;
    const int h = 7 - (unit >> 8), iq = 63 - ((unit & 255) >> 2), b = unit & 3, bh = b * 8 + h;
    const int q0 = LEAD + 128 * iq, qpos = q0 + 32 * sb + r32, ktl = 2 * iq + 3;
    const float c = exp2f(-(float)(h + 1)) * LOG2E;
    const int Dk = (int)((2.0f * smax2 + 152.0f) / c) + 2;
    const int klo = (q0 - Dk > 128) ? ((q0 - Dk) >> 6) : 2;
    bf16x8 qf[4];
    {   const bf16_t* qrow = q.PROJ + ((size_t)b * LTOT + qpos) * PLD + h * 128 + mp * 64 + hi * 8;
#pragma unroll
        for (int d0 = 0; d0 < 4; ++d0) qf[d0] = *(const bf16x8*)(qrow + d0 * 16); }
    f32x16 O[4];
#pragma unroll
    for (int vb = 0; vb < 4; ++vb)
#pragma unroll
        for (int e = 0; e < 16; ++e) O[vb][e] = 0.f;
    float l = 0.f;
    const bf16_t* kg = q.PROJ + ((size_t)b * LTOT) * PLD + 1024 + h * 128;
    const bf16_t* vg = q.VT + ((size_t)bh * 128) * LTOT;
    const int kkey = tid >> 3, kch = tid & 7, vv = tid >> 2, vch = tid & 3;
    u32x4 pk0A, pk1A, pv0A, pv1A, pk0B, pk1B, pv0B, pv1B;
#define A2_LOADK(S, kt_) do { const bf16_t* a_ = kg + (size_t)(64 * (kt_) + kkey) * PLD + kch * 8; pk0##S = *(const u32x4*)a_; pk1##S = *(const u32x4*)(a_ + 64); } while (0)
#define A2_LOADV(S, kt_) do { const bf16_t* v_ = vg + (size_t)vv * LTOT + 64 * (kt_) + vch * 8; pv0##S = *(const u32x4*)v_; pv1##S = *(const u32x4*)(v_ + 32); } while (0)
#define A2_STOREK(S, buf_) do { lds_u8* kb_ = lds + (buf_) * 17408 + kkey * 272 + kch * 16; *(LAS u32x4*)kb_ = pk0##S; *(LAS u32x4*)(kb_ + 128) = pk1##S; } while (0)
#define A2_STOREV(S, buf_) do { lds_u8* vb_ = lds + 34816 + (buf_) * 17408 + vv * 136 + vch * 16; *(LAS u32x2*)vb_ = (u32x2){pv0##S.x, pv0##S.y}; *(LAS u32x2*)(vb_ + 8) = (u32x2){pv0##S.z, pv0##S.w}; \
        *(LAS u32x2*)(vb_ + 64) = (u32x2){pv1##S.x, pv1##S.y}; *(LAS u32x2*)(vb_ + 72) = (u32x2){pv1##S.z, pv1##S.w}; } while (0)
#define A2_NEXT(k_) (((k_) > klo) ? (k_) - 1 : ((k_) > 1 ? 1 : 0))
#define A2_QK(kt_, Kb_) \
        const bool first = ((kt_) == 1); const float ce = first ? 0.f : c; const float b0 = first ? 0.f : c * (float)(64 * (kt_) + 4 * hi - qpos); \
        f32x16 S0, S1; \
        _Pragma("unroll") for (int e = 0; e < 16; ++e) { S0[e] = 0.f; S1[e] = 0.f; } \
        _Pragma("unroll") for (int d0 = 0; d0 < 4; ++d0) { \
            const bf16x8 a0 = ld16((Kb_) + r32 * 272 + mp * 128 + d0 * 32 + hi * 16), a1 = ld16((Kb_) + (32 + r32) * 272 + mp * 128 + d0 * 32 + hi * 16); \
            S0 = mfma32(a0, qf[d0], S0); S1 = mfma32(a1, qf[d0], S1); } \
        const float mb = smax2 - b0;
#define A2_BIAS(kt_) \
        _Pragma("unroll") for (int e = 0; e < 16; ++e) { const float kr = (float)((e & 3) + 8 * (e >> 2)); S0[e] = fmaf(ce, kr, S0[e]); S1[e] = fmaf(ce, kr + 32.0f, S1[e]); } \
        if (first) { asm volatile(""); _Pragma("unroll") for (int e = 0; e < 16; ++e) { S0[e] = -INFINITY; if (e < 8) S1[e] = -INFINITY; } } \
        if ((kt_) >= ktl - 1) { asm volatile(""); const int kb0 = 64 * (kt_) + 4 * hi; \
            _Pragma("unroll") for (int e = 0; e < 16; ++e) { const int key = kb0 + (e & 3) + 8 * (e >> 2); if (key > qpos) S0[e] = -INFINITY; if (key + 32 > qpos) S1[e] = -INFINITY; } }
#define A2_PACK(dst) do { _Pragma("unroll") for (int ks = 0; ks < 2; ++ks) { u32x4 t0, t1; \
            t0.x = pk2(S0[8 * ks + 0], S0[8 * ks + 1]); t0.y = pk2(S0[8 * ks + 2], S0[8 * ks + 3]); t0.z = pk2(S0[8 * ks + 4], S0[8 * ks + 5]); t0.w = pk2(S0[8 * ks + 6], S0[8 * ks + 7]); \
            t1.x = pk2(S1[8 * ks + 0], S1[8 * ks + 1]); t1.y = pk2(S1[8 * ks + 2], S1[8 * ks + 3]); t1.z = pk2(S1[8 * ks + 4], S1[8 * ks + 5]); t1.w = pk2(S1[8 * ks + 6], S1[8 * ks + 7]); \
            dst[0][ks] = __builtin_bit_cast(bf16x8, t0); dst[1][ks] = __builtin_bit_cast(bf16x8, t1); } } while (0)
#define A2_VFRAG(Vb_, g_) ({ const lds_u8* ap_ = (Vb_) + (32 * ((g_) >> 2) + r32) * 136 + (32 * (((g_) >> 1) & 1) + 16 * ((g_) & 1) + 4 * hi) * 2; \
        const u32x2 lo_ = *(const LAS u32x2*)ap_, hh_ = *(const LAS u32x2*)(ap_ + 16); const u32x4 av_ = {lo_.x, lo_.y, hh_.x, hh_.y}; __builtin_bit_cast(bf16x8, av_); })
    bf16x8 pf[2][2];
    const int k0 = ktl, k1 = A2_NEXT(k0), k2 = k1 ? A2_NEXT(k1) : 0;
    A2_LOADK(A, k0);
    if (k1) A2_LOADK(B, k1);
    A2_LOADV(B, k0);
    A2_STOREK(A, 0);
    LDS_BAR();
    {
        if (k2) A2_LOADK(A, k2);
        if (k1) A2_LOADV(A, k1);
        A2_QK(k0, lds)
        A2_BIAS(k0)
        float sum = 0.f;
#pragma unroll
        for (int e = 0; e < 16; ++e) { S0[e] = __builtin_amdgcn_exp2f(S0[e] - mb); S1[e] = __builtin_amdgcn_exp2f(S1[e] - mb); sum += S0[e] + S1[e]; }
        l += sum;
        A2_PACK(pf);
        if (k1) A2_STOREK(B, 1);
        A2_STOREV(B, 0);
        LDS_BAR();
    }
    int kt = k1, lastpar = 0; bool done = (k1 == 0);
#pragma unroll 1
    while (!done) {
#pragma unroll
      for (int cc = 0; cc < 2; ++cc) { const int par = cc ^ 1;
        const int knext = A2_NEXT(kt), knn = knext ? A2_NEXT(knext) : 0;
        if (par) { if (knn) A2_LOADK(B, knn); if (knext) A2_LOADV(B, knext); } else { if (knn) A2_LOADK(A, knn); if (knext) A2_LOADV(A, knext); }
        const lds_u8* Kb = lds + par * 17408; const lds_u8* Vb = lds + 34816 + (par ^ 1) * 17408;
        A2_QK(kt, Kb)
        bf16x8 vf0 = A2_VFRAG(Vb, 0), vf1;
        A2_BIAS(kt)
        float sum = 0.f;
#pragma unroll
        for (int g = 0; g < 16; ++g) {
            if (g + 1 < 16) { if (g & 1) vf0 = A2_VFRAG(Vb, g + 1); else vf1 = A2_VFRAG(Vb, g + 1); }
            O[g >> 2] = mfma32((g & 1) ? vf1 : vf0, pf[(g >> 1) & 1][g & 1], O[g >> 2]);
            S0[g] = __builtin_amdgcn_exp2f(S0[g] - mb); S1[g] = __builtin_amdgcn_exp2f(S1[g] - mb); sum += S0[g] + S1[g];
            __builtin_amdgcn_sched_barrier(0);
        }
        l += sum;
        A2_PACK(pf);
        if (par) { if (knext) A2_STOREK(A, 0); A2_STOREV(A, 1); } else { if (knext) A2_STOREK(B, 1); A2_STOREV(B, 0); }
        LDS_BAR();
        lastpar = par;
        if (!knext) { done = true; break; }
        kt = knext;
      }
    }
    {
        const lds_u8* Vb = lds + 34816 + lastpar * 17408;
#pragma unroll
        for (int g = 0; g < 16; ++g) O[g >> 2] = mfma32(A2_VFRAG(Vb, g), pf[(g >> 1) & 1][g & 1], O[g >> 2]);
        LDS_BAR();
    }
#undef A2_LOADK
#undef A2_LOADV
#undef A2_STOREK
#undef A2_STOREV
#undef A2_NEXT
#undef A2_QK
#undef A2_BIAS
#undef A2_PACK
#undef A2_VFRAG
    const float inv = 1.0f / pl32_sum(l);
    LAS float* comb = (LAS float*)lds + sb * 4096;
    if (mp == 1) {
#pragma unroll
        for (int vb = 0; vb < 4; ++vb)
#pragma unroll
            for (int e = 0; e < 16; ++e) comb[(32 * vb + crow(e, hi)) * 32 + r32] = O[vb][e] * inv;
    }
    LDS_BAR();
    if (mp == 0) {
        float ss = 0.f;
#pragma unroll
        for (int vb = 0; vb < 4; ++vb)
#pragma unroll
            for (int e = 0; e < 16; ++e) { const float o = O[vb][e] * inv - lam * comb[(32 * vb + crow(e, hi)) * 32 + r32]; O[vb][e] = o; ss += o * o; }
        ss = pl32_sum(ss);
        const float rs = rsqrtf(ss * (1.0f / 128.0f) + EPS) * 0.8f;
        bf16_t* orow = q.OCAT + ((size_t)b * SEQ + (qpos - LEAD)) * DM + h * 128;
        u32x2 ov[4][4];
#pragma unroll
        for (int vb = 0; vb < 4; ++vb)
#pragma unroll
            for (int g = 0; g < 4; ++g) { const int v0 = 32 * vb + 8 * g + 4 * hi; const f32x4 sw = *(const f32x4*)(p.subln_w + v0);
                ov[vb][g].x = pk2(O[vb][4 * g] * rs * sw[0], O[vb][4 * g + 1] * rs * sw[1]); ov[vb][g].y = pk2(O[vb][4 * g + 2] * rs * sw[2], O[vb][4 * g + 3] * rs * sw[3]); }
#pragma unroll
        for (int vb = 0; vb < 4; ++vb)
#pragma unroll
            for (int g = 0; g < 4; ++g) *(u32x2*)(orow + 32 * vb + 8 * g + 4 * hi) = ov[vb][g];
    }
    LDS_BAR();
}

DI unsigned long long rd_u64(const LAS unsigned long long* a) { const unsigned long long v = *a; const unsigned lo = __builtin_amdgcn_readfirstlane((unsigned)v), hi = __builtin_amdgcn_readfirstlane((unsigned)(v >> 32)); return ((unsigned long long)hi << 32) | lo; }
#define PARAM_FIELDS(X) X(x,0) X(meta,1) X(attn_norm_w,2) X(w_in,3) X(q_norm_w,4) X(k_norm_w,5) X(lq1,6) X(lk1,7) X(lq2,8) X(lk2,9) X(subln_w,10) X(conv_w,11) X(a_log,12) X(dt_bias,13) X(o_norm_w,14) X(w_out,15) X(ffn_norm_w,16) X(w_gate,17) X(w_up,18) X(w_down,19)
DI Params load_params(const lds_u8* lds) {
    const LAS unsigned long long* PL = (const LAS unsigned long long*)(lds + PARAM_OFF); Params p;
#define X(f, i) p.f = (const float*)(const GAS float*)rd_u64(PL + i);
    PARAM_FIELDS(X)
#undef X
    p.out = (float*)(GAS float*)rd_u64(PL + 20); p.ws = (unsigned char*)(GAS unsigned char*)rd_u64(PL + 21);
    return p;
}
DI Ptrs make_ptrs(const Params& p) {
    Ptrs q; unsigned char* ws = p.ws;
    q.ctl = (unsigned*)(ws + OFF_CTL); q.rstd1 = (float*)(ws + OFF_RSTD1); q.ss2 = (float*)(ws + OFF_SS2); q.egl = (float*)(ws + OFF_EGL); q.BA = (float*)(ws + OFF_BA);
    q.WinT = (bf16_t*)(ws + OFF_WIN); q.WoutT = (bf16_t*)(ws + OFF_WOUT); q.WguT = (bf16_t*)(ws + OFF_WGU); q.WdT = (bf16_t*)(ws + OFF_WD);
    q.XB = (bf16_t*)(ws + OFF_XB); q.OCAT = q.XB; q.PROJ = (bf16_t*)(ws + OFF_PROJ); q.HID = q.PROJ;
    q.KGT = (bf16_t*)(ws + OFF_KGT); q.QK = (bf16_t*)(ws + OFF_QK); q.VT = (bf16_t*)(ws + OFF_VT); q.H1B = (bf16_t*)(ws + OFF_H1B);
    unsigned char* o = (unsigned char*)p.out; q.UT = (bf16_t*)o; q.W = (bf16_t*)(o + DN_BYTES); q.QG = (bf16_t*)(o + 2 * DN_BYTES);
    return q;
}
__global__ void __launch_bounds__(NTHR, 2) hymba_fwd(Params pk) {
    extern __shared__ __attribute__((aligned(16))) unsigned char lds_raw[];
    cg::grid_group grid = cg::this_grid();
    lds_u8* lds = (lds_u8*)lds_raw;
    const int tid = threadIdx.x;
    if (tid == 0) { LAS unsigned long long* PL = (LAS unsigned long long*)(lds + PARAM_OFF);
#define X(f, i) PL[i] = (unsigned long long)pk.f;
        PARAM_FIELDS(X)
#undef X
        PL[20] = (unsigned long long)pk.out; PL[21] = (unsigned long long)pk.ws;
        ((LAS unsigned*)(lds + MISC_OFF))[8] = 0u; ((LAS unsigned*)(lds + MISC_OFF))[9] = 0u; }
    __syncthreads();
    const int G = gridDim.x;

    {   const Params p = load_params(lds); const Ptrs q = make_ptrs(p);
        int t0 = threadIdx.x; asm volatile("" : "+v"(t0));
        p0_prologue(p, q, lds, t0);
#if PROBE == 10
        __syncthreads(); p0_prologue(p, q, lds, t0);
#endif
        }
    grid.sync();
    const XcdBarrier xbar = xcd_barrier_post((unsigned*)(pk.ws + OFF_BAR), (volatile LAS unsigned*)(lds + MISC_OFF) + 8);
    {   const Params p = load_params(lds); const Ptrs q = make_ptrs(p);
        pg8::Gemm g{q.XB, q.WinT, MTOT, INPAD, DM}; pg8::StaticOrder S; S.init(MTOT, INPAD, G, (int)blockIdx.x);
        pg8::EpiProj E{q.PROJ, q.BA, q.rstd1};
        pg8::gemm_phase<pg8::EpiProj, pg8::StaticOrder, true, true>(lds, g, S, E);
#if PROBE == 1
        __syncthreads(); pg8::gemm_phase<pg8::EpiProj, pg8::StaticOrder, true, true>(lds, g, S, E);
#endif
        }
    xcd_barrier(xbar);
    {   const Params p = load_params(lds); const Ptrs q = make_ptrs(p);
        int t2 = threadIdx.x; asm volatile("" : "+v"(t2)); const int tid = t2, lane = tid & 63, wave = __builtin_amdgcn_readfirstlane(tid >> 6);
        const int gw = blockIdx.x * NWAVES + wave, NGW = G * NWAVES;
#if PROBE == 23
        for (int r = gw; r < MTOT; r += NGW) qknorm_row(p, q, r, lane);
#endif
        for (int it = gw; it < NITEM; it += NGW) vt_item(q, lds + wave * 17408, it, lane);
        __syncthreads();
#if PROBE == 23
        for (int it = blockIdx.x; it < NITEM; it += G) dn_prep_item(p, q, lds, it, tid);
#else
        dn_prep_phase(p, q, lds, tid, G);
#endif
#if PROBE == 2 || PROBE == 21
        for (int it = gw; it < NITEM; it += NGW) vt_item(q, lds + wave * 17408, it, lane);
        __syncthreads();
#endif
#if PROBE == 2 || PROBE == 22
        for (int it = blockIdx.x; it < NITEM; it += G) dn_prep_item(p, q, lds, it, tid);
#endif
        }
    xcd_barrier(xbar);
    {   const Params p = load_params(lds); const Ptrs q = make_ptrs(p);
        int t3 = threadIdx.x; asm volatile("" : "+v"(t3)); const int tid = t3;
        if ((int)blockIdx.x < NBH) dn_scan(p, q, lds, (int)blockIdx.x, tid);
#if PROBE == 4
        if ((int)blockIdx.x < NBH) { __syncthreads(); dn_scan(p, q, lds, (int)blockIdx.x, tid); }
#endif
        float s1 = 0.f, s2 = 0.f;
        for (int i = 0; i < 64; ++i) { s1 += p.lq1[i] * p.lk1[i]; s2 += p.lq2[i] * p.lk2[i]; }
        const float lam = expf(s1) - expf(s2) + 0.2f;
        float qwm = 0.f, kwm = 0.f;
        for (int i = 0; i < 64; ++i) { qwm = fmaxf(qwm, fabsf(p.q_norm_w[i])); kwm = fmaxf(kwm, fabsf(p.k_norm_w[i])); }
        const float smax2 = 8.0f * qwm * kwm * LOG2E * 1.03f;
        volatile LAS unsigned* misc = (volatile LAS unsigned*)(lds + MISC_OFF);
        const int xcd = (int)(__builtin_amdgcn_s_getreg((3 << 11) | 20) & 7u);
        int xstart = xcd;
        for (;;) {
            if (tid == 0) { unsigned code = 0xffffffffu; int xx = xstart;
                for (int a = 0; a < 8; ++a) { const unsigned j = atomicAdd(q.ctl + 8 * xx, 1u); if (j < 256u) { code = ((unsigned)xx << 8) | j; break; } xx = (xx + 1) & 7; }
                xstart = xx; misc[0] = code; }
            __syncthreads();
            const unsigned code = (unsigned)__builtin_amdgcn_readfirstlane((int)misc[0]);
            if (code == 0xffffffffu) break;
            const int xq = (int)(code >> 8), jq = (int)(code & 255u), slot = jq >> 6;
            const int hq = (xq < 4) ? (slot == 0 ? 7 : slot == 1 ? 5 : slot == 2 ? 2 : 0) : (slot == 0 ? 6 : slot == 1 ? 4 : slot == 2 ? 3 : 1);
            const int u = (7 - hq) * 256 + (jq & 63) * 4 + (xq & 3);
#if PROBE == 30
            attn_unit2(p, q, lds, u, tid, lam, smax2);
#else
            attn_unit(p, q, lds, u, tid, lam, smax2);
#endif
        } }
    xcd_barrier(xbar);
#if PROBE == 3
    {   const Params p = load_params(lds); const Ptrs q = make_ptrs(p);
        if (blockIdx.x == 0 && threadIdx.x == 0) q.ctl[0] = 0u;
        grid.sync();
        int t3 = threadIdx.x; asm volatile("" : "+v"(t3)); const int tid = t3;
        if ((int)blockIdx.x < NBH) dn_scan(p, q, lds, (int)blockIdx.x, tid);
        float s1 = 0.f, s2 = 0.f;
        for (int i = 0; i < 64; ++i) { s1 += p.lq1[i] * p.lk1[i]; s2 += p.lq2[i] * p.lk2[i]; }
        const float lam = expf(s1) - expf(s2) + 0.2f;
        float qwm = 0.f, kwm = 0.f;
        for (int i = 0; i < 64; ++i) { qwm = fmaxf(qwm, fabsf(p.q_norm_w[i])); kwm = fmaxf(kwm, fabsf(p.k_norm_w[i])); }
        const float smax2 = 8.0f * qwm * kwm * LOG2E * 1.03f;
        volatile LAS unsigned* misc = (volatile LAS unsigned*)(lds + MISC_OFF);
        for (;;) {
            if (tid == 0) misc[0] = atomicAdd(q.ctl, 1u);
            __syncthreads();
            const int u = __builtin_amdgcn_readfirstlane((int)misc[0]);
            if (u >= N_ATT_UNITS) break;
#if PROBE == 30
            attn_unit2(p, q, lds, u, tid, lam, smax2);
#else
            attn_unit(p, q, lds, u, tid, lam, smax2);
#endif
        } }
    grid.sync();
#endif
    {   const Params p = load_params(lds); const Ptrs q = make_ptrs(p);
        pg8::Gemm g{q.OCAT, q.WoutT, MREAL, DM, DM}; pg8::StaticOrder S; S.init(MREAL, DM, G, (int)blockIdx.x);
        pg8::EpiOut E{p.x, p.out, q.H1B, q.ss2};
        pg8::gemm_phase<pg8::EpiOut, pg8::StaticOrder, true, true>(lds, g, S, E); }
    xcd_barrier(xbar);
    {   const Params p = load_params(lds); const Ptrs q = make_ptrs(p);
        pg8::Gemm g{q.H1B, q.WguT, MREAL, 2 * FF, DM}; pg8::StaticOrder S; S.init(MREAL, 2 * FF, G, (int)blockIdx.x);
        pg8::EpiGU E{q.ss2, q.HID};
        pg8::gemm_phase<pg8::EpiGU, pg8::StaticOrder, true, true>(lds, g, S, E);
#if PROBE == 5
        __syncthreads(); pg8::gemm_phase<pg8::EpiGU, pg8::StaticOrder, true, true>(lds, g, S, E);
#endif
        }
    xcd_barrier(xbar);
    {   const Params p = load_params(lds); const Ptrs q = make_ptrs(p);
        pg8::Gemm g{q.HID, q.WdT, MREAL, DM, FF}; pg8::StaticOrder S; S.init(MREAL, DM, G, (int)blockIdx.x);
        pg8::EpiDown E{q.H1B, p.out};
        pg8::gemm_phase<pg8::EpiDown, pg8::StaticOrder, true, true>(lds, g, S, E); }
}

extern "C" void kernel_launch(void* const* d_in, const int* in_sizes, int n_in, void* d_out, int out_size, void* d_ws, size_t ws_size, hipStream_t stream) {
    static int grid = 0;
    if (grid == 0) {
        if (n_in != 20 || out_size != MREAL * DM || ws_size < WS_NEED) { fprintf(stderr, "kernel_launch: unexpected shapes (n_in %d, out %d, ws %zu, need %zu)\n", n_in, out_size, ws_size, (size_t)WS_NEED); grid = -1; return; }
        int dev = 0, cus = 0, per_cu = 0;
        hipGetDevice(&dev); hipDeviceGetAttribute(&cus, hipDeviceAttributeMultiprocessorCount, dev);
        if (hipFuncSetAttribute((const void*)hymba_fwd, hipFuncAttributeMaxDynamicSharedMemorySize, LDS_BYTES) != hipSuccess) { fprintf(stderr, "kernel_launch: hipFuncSetAttribute failed\n"); grid = -1; return; }
        if (hipOccupancyMaxActiveBlocksPerMultiprocessor(&per_cu, (const void*)hymba_fwd, NTHR, LDS_BYTES) != hipSuccess || per_cu < 1) { fprintf(stderr, "kernel_launch: occupancy query says %d\n", per_cu); per_cu = 1; }
        (void)hipGetLastError();
        grid = cus;
    }
    if (grid < 0) return;
    Params p{};
    const float** pp = (const float**)&p;
    for (int i = 0; i < 20; ++i) pp[i] = (const float*)d_in[i];
    p.out = (float*)d_out; p.ws = (unsigned char*)d_ws;
    void* args[] = {&p};
    hipError_t e = hipLaunchCooperativeKernel((const void*)hymba_fwd, dim3(grid), dim3(NTHR), args, LDS_BYTES, stream);
    if (e != hipSuccess) fprintf(stderr, "kernel_launch: cooperative launch failed: %s (grid %d)\n", hipGetErrorString(e), grid);
}
```
